# Optimizing an MI355X kernel written in HIP

```python
import math
import jax, jax.numpy as jnp
from jax import lax
import numpy as np

D_MODEL = 4096
BATCH = 2
SEQ = 4096
DEPTH = 2

RET_HEADS = 8
RET_QK_DIM = 64
RET_V_DIM = 128
RET_CHUNK = 128
RET_ROPE_THETA = 10000.0

DSA_HEADS = 12
DSA_KV_HEADS = 4
DSA_HEAD_DIM = 128
IDX_HEADS = 32
IDX_HEAD_DIM = 128
DSA_TOPK = 256
PARTIAL_ROT_DIM = DSA_HEAD_DIM // 4
IDX_ROT_DIM = IDX_HEAD_DIM // 4
PARTIAL_ROPE_THETA = 500000.0

MLA_HEADS = 12
MLA_Q_LORA = 768
MLA_KV_LORA = 256
MLA_NOPE_DIM = 128
MLA_ROPE_DIM = 64
MLA_V_DIM = 128
MLA_ROPE_THETA = 10000.0

Q_BLOCK = 128
D_FF = 4 * D_MODEL
NORM_EPS = 1e-6

RET_OUT = RET_HEADS * RET_V_DIM
DSA_OUT = DSA_HEADS * DSA_HEAD_DIM
MLA_OUT = MLA_HEADS * MLA_V_DIM
MIX_WIDTH = RET_OUT + DSA_OUT + MLA_OUT

IN_SPLITS = (
    RET_HEADS * RET_QK_DIM,
    RET_HEADS * RET_QK_DIM,
    RET_OUT,
    RET_OUT,
    DSA_HEADS * DSA_HEAD_DIM,
    DSA_KV_HEADS * DSA_HEAD_DIM,
    DSA_KV_HEADS * DSA_HEAD_DIM,
    IDX_HEADS * IDX_HEAD_DIM,
    IDX_HEAD_DIM,
    IDX_HEADS,
    MLA_Q_LORA,
    MLA_KV_LORA,
    MLA_ROPE_DIM,
)
IN_WIDTH = sum(IN_SPLITS)

kernel_name = "hybrid_retention_dsa_mla_block"


def rms_norm(x, g):
    xf = x.astype(jnp.float32)
    y = xf * lax.rsqrt(jnp.mean(xf * xf, axis=-1, keepdims=True) + NORM_EPS)
    return (y * g.astype(jnp.float32)).astype(x.dtype)


def rope(x, pos, theta, rot_dim):
    half = rot_dim // 2
    inv = jnp.exp(-math.log(theta) * jnp.arange(half, dtype=jnp.float32) * (2.0 / rot_dim))
    ang = pos[:, None] * inv[None, :]
    cos = jnp.cos(ang)[None, :, None, :]
    sin = jnp.sin(ang)[None, :, None, :]
    xr = x[..., :rot_dim].astype(jnp.float32)
    x1, x2 = xr[..., :half], xr[..., half:]
    rot = jnp.concatenate([x1 * cos - x2 * sin, x2 * cos + x1 * sin], axis=-1).astype(x.dtype)
    return jnp.concatenate([rot, x[..., rot_dim:]], axis=-1)


def split_points():
    pts, acc = [], 0
    for s in IN_SPLITS[:-1]:
        acc += s
        pts.append(acc)
    return pts


def to_query_blocks(a):
    B, T = a.shape[0], a.shape[1]
    return jnp.moveaxis(a.reshape(B, T // Q_BLOCK, Q_BLOCK, *a.shape[2:]), 1, 0)


def retention(q, k, v, gate):
    f32 = jnp.float32
    B, T, H, dk = q.shape
    dv = v.shape[-1]
    C = RET_CHUNK
    N = T // C
    pos = jnp.arange(T, dtype=f32)
    q = rope(q, pos, RET_ROPE_THETA, dk).astype(f32)
    k = rope(k, pos, RET_ROPE_THETA, dk).astype(f32) * (dk ** -0.5)
    v = v.astype(f32)
    log_gamma = jnp.log1p(-jnp.exp2(-5.0 - jnp.arange(H, dtype=f32)))
    idx = jnp.arange(C, dtype=f32)
    rel = idx[:, None] - idx[None, :]
    inner_decay = jnp.where(rel[None] >= 0,
                            jnp.exp(jnp.maximum(rel, 0.0)[None] * log_gamma[:, None, None]),
                            0.0)
    q_decay = jnp.exp((idx + 1.0)[None, :] * log_gamma[:, None])
    k_decay = jnp.exp((C - 1.0 - idx)[None, :] * log_gamma[:, None])
    chunk_decay = jnp.exp(C * log_gamma)

    def to_chunks(a):
        return a.reshape(B, N, C, H, a.shape[-1]).transpose(1, 0, 3, 2, 4)

    def step(state, inp):
        qi, ki, vi = inp
        scores = jnp.einsum('bhid,bhjd->bhij', qi, ki) * inner_decay
        inner = jnp.einsum('bhij,bhjv->bhiv', scores, vi)
        cross = jnp.einsum('bhid,bhdv->bhiv', qi * q_decay[None, :, :, None], state)
        new_state = state * chunk_decay[None, :, None, None] + jnp.einsum(
            'bhjd,bhjv->bhdv', ki * k_decay[None, :, :, None], vi)
        return new_state, inner + cross

    state0 = jnp.zeros((B, H, dk, dv), f32)
    _, out = lax.scan(step, state0, (to_chunks(q), to_chunks(k), to_chunks(v)))
    out = out.transpose(1, 0, 3, 2, 4).reshape(B, T, H, dv)
    out = out * lax.rsqrt(jnp.mean(out * out, axis=-1, keepdims=True) + NORM_EPS)
    out = out.reshape(B, T, H * dv)
    return (jax.nn.silu(gate.astype(f32)) * out).astype(gate.dtype)


def dsa_attention(q, k, v, q_idx, k_idx, w_idx):
    f32 = jnp.float32
    B, T, H, d = q.shape
    Hkv = k.shape[2]
    G = H // Hkv
    top_k = min(DSA_TOPK, T // 4)
    pos = jnp.arange(T, dtype=f32)
    q = rope(q, pos, PARTIAL_ROPE_THETA, PARTIAL_ROT_DIM)
    k = rope(k, pos, PARTIAL_ROPE_THETA, PARTIAL_ROT_DIM)
    q_idx = rope(q_idx, pos, PARTIAL_ROPE_THETA, IDX_ROT_DIM)
    k_idx = rope(k_idx[:, :, None, :], pos, PARTIAL_ROPE_THETA, IDX_ROT_DIM)[:, :, 0, :]
    w_idx = w_idx.astype(f32) * (IDX_HEADS ** -0.5)
    key_pos = jnp.arange(T)

    def one_block(args):
        qb, qib, wb, start = args
        qpos = start + jnp.arange(Q_BLOCK)
        causal = key_pos[None, :] <= qpos[:, None]
        logits = jnp.einsum('bqhd,bsd->bqhs', qib, k_idx).astype(f32) * (IDX_HEAD_DIM ** -0.5)
        index_score = jnp.einsum('bqhs,bqh->bqs', jax.nn.relu(logits), wb)
        index_score = jnp.where(causal[None], index_score, -jnp.inf)
        _, sel = lax.top_k(index_score, top_k)
        valid = sel <= qpos[None, :, None]
        k_sel = jax.vmap(lambda kb, ib: kb[ib])(k, sel)
        v_sel = jax.vmap(lambda vb, ib: vb[ib])(v, sel)
        qg = qb.reshape(B, Q_BLOCK, Hkv, G, d)
        s = jnp.einsum('bqngd,bqknd->bqngk', qg, k_sel).astype(f32) * (d ** -0.5)
        s = jnp.where(valid[:, :, None, None, :], s, -jnp.inf)
        p = jax.nn.softmax(s, axis=-1).astype(v.dtype)
        o = jnp.einsum('bqngk,bqknd->bqngd', p, v_sel)
        return o.reshape(B, Q_BLOCK, H * d)

    starts = jnp.arange(T // Q_BLOCK) * Q_BLOCK
    out = lax.map(one_block, (to_query_blocks(q), to_query_blocks(q_idx),
                              to_query_blocks(w_idx), starts))
    return jnp.moveaxis(out, 0, 1).reshape(B, T, H * d)


def mla_attention(c_q, c_kv, k_rope, q_norm, kv_norm, w_uq, w_ukv):
    f32 = jnp.float32
    B, T, _ = c_q.shape
    H = MLA_HEADS
    pos = jnp.arange(T, dtype=f32)
    q = (rms_norm(c_q, q_norm) @ w_uq).reshape(B, T, H, MLA_NOPE_DIM + MLA_ROPE_DIM)
    q_nope, q_pe = q[..., :MLA_NOPE_DIM], q[..., MLA_NOPE_DIM:]
    q_pe = rope(q_pe, pos, MLA_ROPE_THETA, MLA_ROPE_DIM)
    kv = (rms_norm(c_kv, kv_norm) @ w_ukv).reshape(B, T, H, MLA_NOPE_DIM + MLA_V_DIM)
    k_nope, v = kv[..., :MLA_NOPE_DIM], kv[..., MLA_NOPE_DIM:]
    k_pe = rope(k_rope[:, :, None, :], pos, MLA_ROPE_THETA, MLA_ROPE_DIM)
    q_full = jnp.concatenate([q_nope, q_pe], axis=-1)
    k_full = jnp.concatenate([k_nope, jnp.broadcast_to(k_pe, (B, T, H, MLA_ROPE_DIM))], axis=-1)
    scale = (MLA_NOPE_DIM + MLA_ROPE_DIM) ** -0.5
    key_pos = jnp.arange(T)

    def one_block(args):
        qb, start = args
        qpos = start + jnp.arange(Q_BLOCK)
        causal = key_pos[None, :] <= qpos[:, None]
        s = jnp.einsum('bqhd,bshd->bhqs', qb, k_full).astype(f32) * scale
        s = jnp.where(causal[None, None], s, -jnp.inf)
        p = jax.nn.softmax(s, axis=-1).astype(v.dtype)
        o = jnp.einsum('bhqs,bshv->bqhv', p, v)
        return o.reshape(B, Q_BLOCK, H * MLA_V_DIM)

    starts = jnp.arange(T // Q_BLOCK) * Q_BLOCK
    out = lax.map(one_block, (to_query_blocks(q_full), starts))
    return jnp.moveaxis(out, 0, 1).reshape(B, T, H * MLA_V_DIM)


def setup_inputs(seed: int = 0) -> dict:
    key = jax.random.key(seed)
    ks = jax.random.split(key, 16)
    f32 = jnp.float32
    nrm = lambda k, shape, fan_in: jax.random.normal(k, shape, f32) * (fan_in ** -0.5)
    gain = lambda k, shape: 1.0 + 0.02 * jax.random.normal(k, shape, f32)
    return {
        "x": jax.random.normal(ks[0], (BATCH, SEQ, D_MODEL), f32),
        "attn_norm": gain(ks[1], (DEPTH, D_MODEL)),
        "w_in": nrm(ks[2], (DEPTH, D_MODEL, IN_WIDTH), D_MODEL),
        "mla_q_norm": gain(ks[3], (DEPTH, MLA_Q_LORA)),
        "mla_kv_norm": gain(ks[4], (DEPTH, MLA_KV_LORA)),
        "w_uq": nrm(ks[5], (DEPTH, MLA_Q_LORA, MLA_HEADS * (MLA_NOPE_DIM + MLA_ROPE_DIM)), MLA_Q_LORA),
        "w_ukv": nrm(ks[6], (DEPTH, MLA_KV_LORA, MLA_HEADS * (MLA_NOPE_DIM + MLA_V_DIM)), MLA_KV_LORA),
        "w_o": nrm(ks[7], (DEPTH, MIX_WIDTH, D_MODEL), MIX_WIDTH),
        "mlp_norm": gain(ks[8], (DEPTH, D_MODEL)),
        "w_up": nrm(ks[9], (DEPTH, D_MODEL, D_FF), D_MODEL),
        "w_down": nrm(ks[10], (DEPTH, D_FF, D_MODEL), D_FF),
        "final_norm": gain(ks[11], (D_MODEL,)),
    }


def reference(x, attn_norm, w_in, mla_q_norm, mla_kv_norm, w_uq, w_ukv, w_o,
              mlp_norm, w_up, w_down, final_norm):
    B, T, _ = x.shape
    pts = split_points()
    h = x
    for l in range(DEPTH):
        u = rms_norm(h, attn_norm[l])
        proj = u @ w_in[l]
        (rq, rk, rv, rg, dq, dk, dv, iq, ik, iw, cq, ckv, kr) = jnp.split(proj, pts, axis=-1)
        ret = retention(rq.reshape(B, T, RET_HEADS, RET_QK_DIM),
                        rk.reshape(B, T, RET_HEADS, RET_QK_DIM),
                        rv.reshape(B, T, RET_HEADS, RET_V_DIM), rg)
        dsa = dsa_attention(dq.reshape(B, T, DSA_HEADS, DSA_HEAD_DIM),
                            dk.reshape(B, T, DSA_KV_HEADS, DSA_HEAD_DIM),
                            dv.reshape(B, T, DSA_KV_HEADS, DSA_HEAD_DIM),
                            iq.reshape(B, T, IDX_HEADS, IDX_HEAD_DIM), ik, iw)
        mla = mla_attention(cq, ckv, kr, mla_q_norm[l], mla_kv_norm[l], w_uq[l], w_ukv[l])
        mixed = jnp.concatenate([ret, dsa, mla], axis=-1)
        h = h + mixed @ w_o[l]
        u = rms_norm(h, mlp_norm[l])
        h = h + jnp.square(jax.nn.relu(u @ w_up[l])) @ w_down[l]
    return rms_norm(h, final_norm)
```

```cpp
#include <hip/hip_runtime.h>
#include <cstdio>
#include <cstdint>
namespace pg8 {
#define PG8_LAS __attribute__((address_space(3)))
typedef unsigned short bf16_t;
typedef short bf16x8 __attribute__((ext_vector_type(8)));
typedef float f32x4 __attribute__((ext_vector_type(4)));
typedef unsigned u32x4 __attribute__((ext_vector_type(4)));
constexpr int BM = 256, BK = 64, HALF = 128, HTB = HALF * BK * 2  , STAGE_BYTES = 8 * HTB, NXCD = 8, WGM = 8;

__host__ __device__ __forceinline__ int lds_byte(int r, int c) { const int st = (r >> 4) * 2 + (c >> 5), rr = r & 15, cc = c & 31, ob = rr * 64 + cc * 2; return st * 1024 + (ob ^ (((ob >> 9) & 1) << 5)); }
__host__ __device__ __forceinline__ void stage_rc(int b, int& R, int& C) { const int st = b / 1024, sb = b % 1024, swz = sb ^ (((sb >> 9) & 1) << 5); R = (st >> 1) * 16 + swz / 64; C = (st & 1) * 32 + (swz % 64) / 2; }
__host__ __device__ __forceinline__ int perm32(int rho) { const int n = rho >> 4, i = rho & 15; return 8 * (i >> 2) + 4 * n + (i & 3); }

struct Unit { int pm, pn; };
struct Gemm { const bf16_t* A; const bf16_t* Bt; int M, N, K; };

struct StaticOrder {
    int nM, nN, nwg, G, c;
    __host__ __device__ void init(int M, int N, int G_, int c_) { nM = M / BM; nN = N / BM; nwg = nM * nN; G = G_; c = c_; }
    __host__ __device__ bool next(int i, Unit& u) const {
        const long L = (long)i * G + c; if (L >= nwg) return false;
        int wgid = (int)L; { const int q = nwg / NXCD, r = nwg % NXCD, xcd = wgid % NXCD, off = wgid / NXCD; wgid = (xcd < r ? xcd * (q + 1) : r * (q + 1) + (xcd - r) * q) + off; }
        const int nig = WGM * nN, gid = wgid / nig, fm = gid * WGM, gsz = (nM - fm) < WGM ? (nM - fm) : WGM;
        u.pm = fm + ((wgid % nig) % gsz); u.pn = (wgid % nig) / gsz; return true;
    }
    __device__ __forceinline__ void a_ready(const Unit&) const {}
    __device__ __forceinline__ void done(const Unit&) const {}
};

__device__ __forceinline__ unsigned cvt_pk_bf16(float lo, float hi) { unsigned r; asm volatile("v_cvt_pk_bf16_f32 %0, %1, %2" : "=v"(r) : "v"(lo), "v"(hi)); return r; }
typedef float f32x2 __attribute__((ext_vector_type(2)));
template <int ACT  > struct EpiBf16 {
    static constexpr bool PERM = true, AFTER_DRAIN = false;
    bf16_t* O; int ldc; size_t tile_stride;
    const float* rowss; float inv_k;
    __device__ __forceinline__ void operator()(const f32x4 (&acc)[2][2][4][2], const Unit& u, int wr, int wc, int fr, int fq) const {
        const int row0 = u.pm * BM + wr * 64 + fr; const int col0 = (tile_stride ? 0 : u.pn * BM) + wc * 32 + 8 * fq;
        bf16_t* Ob = O + (size_t)u.pn * tile_stride;
#pragma unroll
        for (int ai = 0; ai < 2; ++ai)
#pragma unroll
            for (int m = 0; m < 4; ++m) { bf16_t* rowp = Ob + (size_t)(row0 + ai * HALF + m * 16) * ldc + col0;
                const float rs = rowss ? 1.0f / sqrtf(rowss[row0 + ai * HALF + m * 16] * inv_k + 1e-6f) : 1.0f;
#pragma unroll
                for (int bj = 0; bj < 2; ++bj) { f32x4 v0 = acc[ai][bj][m][0] * rs, v1 = acc[ai][bj][m][1] * rs;
                    if (ACT == 1) {
#pragma unroll
                        for (int j = 0; j < 4; ++j) { const float a = fmaxf(v0[j], 0.f), b = fmaxf(v1[j], 0.f); v0[j] = a * a; v1[j] = b * b; } }
                    u32x4 w; w.x = cvt_pk_bf16(v0[0], v0[1]); w.y = cvt_pk_bf16(v0[2], v0[3]); w.z = cvt_pk_bf16(v1[0], v1[1]); w.w = cvt_pk_bf16(v1[2], v1[3]);
                    if (ACT == 1) __builtin_nontemporal_store(w, (u32x4*)(rowp + bj * HALF)); else *(u32x4*)(rowp + bj * HALF) = w; } }
    }
};
struct EpiRes {
    static constexpr bool PERM = true, AFTER_DRAIN = false;
    const float* base32; float* out32; int ldc; bf16_t* hb; float* rowss;
    __device__ __forceinline__ void operator()(const f32x4 (&acc)[2][2][4][2], const Unit& u, int wr, int wc, int fr, int fq) const {
        const int row0 = u.pm * BM + wr * 64 + fr, col0 = u.pn * BM + wc * 32 + 8 * fq;
#pragma unroll
        for (int ai = 0; ai < 2; ++ai)
#pragma unroll
            for (int m = 0; m < 4; ++m) { const int r = row0 + ai * HALF + m * 16; const size_t off = (size_t)r * ldc + col0; float ss = 0.f;
#pragma unroll
                for (int bj = 0; bj < 2; ++bj) { const size_t o1 = off + bj * HALF; f32x4 b0, b1;
                    if (base32) { b0 = *(const f32x4*)(base32 + o1); b1 = *(const f32x4*)(base32 + o1 + 4); }
                    else { const u32x4 w = *(const u32x4*)(hb + o1);
                        b0 = (f32x4){__builtin_bit_cast(float, w.x << 16), __builtin_bit_cast(float, w.x & 0xffff0000u), __builtin_bit_cast(float, w.y << 16), __builtin_bit_cast(float, w.y & 0xffff0000u)};
                        b1 = (f32x4){__builtin_bit_cast(float, w.z << 16), __builtin_bit_cast(float, w.z & 0xffff0000u), __builtin_bit_cast(float, w.w << 16), __builtin_bit_cast(float, w.w & 0xffff0000u)}; }
                    const f32x4 o0 = b0 + acc[ai][bj][m][0], o1v = b1 + acc[ai][bj][m][1];
                    if (out32) { __builtin_nontemporal_store(o0, (f32x4*)(out32 + o1)); __builtin_nontemporal_store(o1v, (f32x4*)(out32 + o1 + 4)); }
                    else { ss += ((o0[0] * o0[0] + o0[1] * o0[1]) + (o0[2] * o0[2] + o0[3] * o0[3])) + ((o1v[0] * o1v[0] + o1v[1] * o1v[1]) + (o1v[2] * o1v[2] + o1v[3] * o1v[3]));
                        u32x4 w; w.x = cvt_pk_bf16(o0[0], o0[1]); w.y = cvt_pk_bf16(o0[2], o0[3]); w.z = cvt_pk_bf16(o1v[0], o1v[1]); w.w = cvt_pk_bf16(o1v[2], o1v[3]); *(u32x4*)(hb + o1) = w; } }
                if (!out32) { ss += __shfl_xor(ss, 16); ss += __shfl_xor(ss, 32);
                    if (fq == 0) __hip_atomic_fetch_add(rowss + r, ss, __ATOMIC_RELAXED, __HIP_MEMORY_SCOPE_AGENT); } }
    }
};
struct EpiFinal {
    static constexpr bool PERM = true, AFTER_DRAIN = false;
    const bf16_t* hb; float* out; int ldc; float* rowss; const float* gfin; unsigned* cnt;
    __device__ __forceinline__ void operator()(const f32x4 (&acc)[2][2][4][2], const Unit& u, int wr, int wc, int fr, int fq) const {
        const int row0 = u.pm * BM + wr * 64 + fr, col0 = u.pn * BM + wc * 32 + 8 * fq;
#pragma unroll
        for (int ai = 0; ai < 2; ++ai)
#pragma unroll
            for (int m = 0; m < 4; ++m) { const int r = row0 + ai * HALF + m * 16; const size_t off = (size_t)r * ldc + col0; float ss = 0.f;
#pragma unroll
                for (int bj = 0; bj < 2; ++bj) { const u32x4 w = *(const u32x4*)(hb + off + bj * HALF);
                    const f32x4 b0 = (f32x4){__builtin_bit_cast(float, w.x << 16), __builtin_bit_cast(float, w.x & 0xffff0000u), __builtin_bit_cast(float, w.y << 16), __builtin_bit_cast(float, w.y & 0xffff0000u)};
                    const f32x4 b1 = (f32x4){__builtin_bit_cast(float, w.z << 16), __builtin_bit_cast(float, w.z & 0xffff0000u), __builtin_bit_cast(float, w.w << 16), __builtin_bit_cast(float, w.w & 0xffff0000u)};
                    const f32x4 o0 = b0 + acc[ai][bj][m][0], o1v = b1 + acc[ai][bj][m][1];
                    ss += ((o0[0] * o0[0] + o0[1] * o0[1]) + (o0[2] * o0[2] + o0[3] * o0[3])) + ((o1v[0] * o1v[0] + o1v[1] * o1v[1]) + (o1v[2] * o1v[2] + o1v[3] * o1v[3])); }
                ss += __shfl_xor(ss, 16); ss += __shfl_xor(ss, 32);
                if (fq == 0) __hip_atomic_fetch_add(rowss + r, ss, __ATOMIC_RELAXED, __HIP_MEMORY_SCOPE_AGENT); }
        asm volatile("s_waitcnt vmcnt(0)" ::: "memory");
        unsigned* c = cnt + u.pm * 64;
        if (fr == 0 && fq == 0) { __hip_atomic_fetch_add(c, 1u, __ATOMIC_RELAXED, __HIP_MEMORY_SCOPE_AGENT);
            int spins = 0; while (__hip_atomic_load(c, __ATOMIC_RELAXED, __HIP_MEMORY_SCOPE_AGENT) < 128u && ++spins < (1 << 22)) __builtin_amdgcn_s_sleep(2); }
        asm volatile("" ::: "memory");
#pragma unroll
        for (int ai = 0; ai < 2; ++ai)
#pragma unroll
            for (int m = 0; m < 4; ++m) { const int r = row0 + ai * HALF + m * 16; const size_t off = (size_t)r * ldc + col0;
                const float rs = 1.0f / sqrtf(__hip_atomic_load(rowss + r, __ATOMIC_RELAXED, __HIP_MEMORY_SCOPE_AGENT) * (1.0f / 4096.0f) + 1e-6f);
#pragma unroll
                for (int bj = 0; bj < 2; ++bj) { const size_t o1 = off + bj * HALF; const u32x4 w = *(const u32x4*)(hb + o1);
                    const f32x4 b0 = (f32x4){__builtin_bit_cast(float, w.x << 16), __builtin_bit_cast(float, w.x & 0xffff0000u), __builtin_bit_cast(float, w.y << 16), __builtin_bit_cast(float, w.y & 0xffff0000u)};
                    const f32x4 b1 = (f32x4){__builtin_bit_cast(float, w.z << 16), __builtin_bit_cast(float, w.z & 0xffff0000u), __builtin_bit_cast(float, w.w << 16), __builtin_bit_cast(float, w.w & 0xffff0000u)};
                    const f32x4 g0 = *(const f32x4*)(gfin + col0 + bj * HALF), g1 = *(const f32x4*)(gfin + col0 + bj * HALF + 4);
                    __builtin_nontemporal_store(((b0 + acc[ai][bj][m][0]) * rs) * g0, (f32x4*)(out + o1)); __builtin_nontemporal_store(((b1 + acc[ai][bj][m][1]) * rs) * g1, (f32x4*)(out + o1 + 4)); } }
    }
};
struct FinalOrder {
    int c;
    __host__ __device__ void init(int, int, int, int c_) { c = c_; }
    __host__ __device__ bool next(int i, Unit& u) const { if (i >= 2) return false; const int x = c & 7, j = c >> 3; u.pm = 16 * i + 8 * (x & 1) + (j & 7); u.pn = 4 * (x >> 1) + (j >> 3); return true; }
    __device__ __forceinline__ void a_ready(const Unit&) const {}
    __device__ __forceinline__ void done(const Unit&) const {}
};
template <class Epi, class Sched, bool ALIGN_EPI = false, bool SP2 = false>
__device__ __forceinline__ void gemm_phase(PG8_LAS unsigned char* lds, const Gemm g, const Sched& S, const Epi& E, const int tid_arg) {
    int tid_ = tid_arg; asm volatile("" : "+v"(tid_));
    const int tid = tid_, wid = __builtin_amdgcn_readfirstlane(tid >> 6), lane = tid & 63, wr = wid >> 2, wc = wid & 3, fr = lane & 15, fq = lane >> 4;
    const int K = g.K, nt = K / BK;
    unsigned voffA[2], voffB[2];
#pragma unroll
    for (int i = 0; i < 2; ++i) { int R, C; stage_rc(tid * 16 + i * 8192, R, C); const int Rb = Epi::PERM ? ((R & ~31) + perm32(R & 31)) : R;
        voffA[i] = (unsigned)(R * K + C) * 2u; voffB[i] = (unsigned)(Rb * K + C) * 2u; }
    const size_t kstep = (size_t)(BK * 2);
    const size_t hstep = (size_t)HALF * K * 2;
    const size_t tstep = 2 * hstep;
    const unsigned ldsw = (unsigned)wid * 1024u;
    const int aoff = lds_byte(wr * 64 + fr, fq * 8), boff = lds_byte(wc * 32 + fr, fq * 8);
#define PG8_SA(b, h) (((b) * 2 + (h)) * HTB)
#define PG8_SB(b, h) ((4 + (b) * 2 + (h)) * HTB)
#define PG8_STAGE(bufoff, gbase, voff) do { _Pragma("unroll") for (int _i = 0; _i < 2; ++_i) \
        __builtin_amdgcn_global_load_lds((const unsigned*)((const char*)(gbase) + (voff)[_i]), (PG8_LAS unsigned*)(lds + (bufoff) + ldsw + _i * 8192), 16, 0, 0); } while (0)
#define PG8_LDA(dst, b, h) do { _Pragma("unroll") for (int m = 0; m < 4; ++m) _Pragma("unroll") for (int k = 0; k < 2; ++k) dst[m][k] = *(const PG8_LAS bf16x8*)(lds + PG8_SA(b, h) + aoff + m * 2048 + k * 1024); } while (0)
#define PG8_LDB(dst, b, h) do { _Pragma("unroll") for (int n = 0; n < 2; ++n) _Pragma("unroll") for (int k = 0; k < 2; ++k) dst[n][k] = *(const PG8_LAS bf16x8*)(lds + PG8_SB(b, h) + boff + n * 2048 + k * 1024); } while (0)
#define PG8_MMA(ai, bj, At, Bt) do { __builtin_amdgcn_s_setprio(1); _Pragma("unroll") for (int m = 0; m < 4; ++m) _Pragma("unroll") for (int n = 0; n < 2; ++n) _Pragma("unroll") for (int k = 0; k < 2; ++k) \
        acc[ai][bj][m][n] = __builtin_amdgcn_mfma_f32_16x16x32_bf16(Bt[n][k], At[m][k], acc[ai][bj][m][n], 0, 0, 0); __builtin_amdgcn_s_setprio(0); } while (0)
#define PG8_WAIT_V(n) asm volatile("s_waitcnt vmcnt(" #n ")" ::: "memory")
#define PG8_WAIT_L(n) asm volatile("s_waitcnt lgkmcnt(" #n ")" ::: "memory")
#define PG8_BAR __builtin_amdgcn_s_barrier()
#define PG8_SCHED __builtin_amdgcn_sched_barrier(0)
    Unit cur, nxt; int ui = 0;
    if (!S.next(0, cur)) return;
    f32x4 acc[2][2][4][2];
#pragma unroll
    for (int a = 0; a < 2; ++a)
#pragma unroll
        for (int b = 0; b < 2; ++b)
#pragma unroll
            for (int m = 0; m < 4; ++m)
#pragma unroll
                for (int n = 0; n < 2; ++n) acc[a][b][m][n] = (f32x4){0.f, 0.f, 0.f, 0.f};
    bf16x8 At[4][2], B0[2][2], B1[2][2];
    const char* cA = (const char*)g.A + (size_t)cur.pm * tstep; const char* cB = (const char*)g.Bt + (size_t)cur.pn * tstep;
    S.a_ready(cur);
    if constexpr (SP2) {
        PG8_STAGE(PG8_SB(0, 0), cB, voffB); PG8_STAGE(PG8_SB(0, 1), cB + hstep, voffB); PG8_STAGE(PG8_SA(0, 0), cA, voffA); PG8_STAGE(PG8_SA(0, 1), cA + hstep, voffA);
        if (wr == 1) PG8_BAR;
        PG8_WAIT_V(2); PG8_BAR;
        PG8_STAGE(PG8_SB(1, 0), cB + kstep, voffB); PG8_STAGE(PG8_SA(1, 0), cA + kstep, voffA); PG8_STAGE(PG8_SB(1, 1), cB + hstep + kstep, voffB);
        PG8_WAIT_V(6); PG8_BAR;
    } else {
        PG8_STAGE(PG8_SB(0, 0), cB, voffB); PG8_STAGE(PG8_SA(0, 0), cA, voffA); PG8_STAGE(PG8_SB(0, 1), cB + hstep, voffB); PG8_STAGE(PG8_SA(0, 1), cA + hstep, voffA);
        if (wr == 1) PG8_BAR;
        PG8_WAIT_V(4); PG8_BAR;
        PG8_STAGE(PG8_SB(1, 0), cB + kstep, voffB); PG8_STAGE(PG8_SA(1, 0), cA + kstep, voffA); PG8_STAGE(PG8_SB(1, 1), cB + hstep + kstep, voffB);
        PG8_WAIT_V(6); PG8_BAR;
    }
    for (;;) {
        const bool has_next = S.next(ui + 1, nxt);
        const char* nA = has_next ? (const char*)g.A + (size_t)nxt.pm * tstep : cA; const char* nB = has_next ? (const char*)g.Bt + (size_t)nxt.pn * tstep : cB;
        for (int t = 0; t < nt; t += 2) {
            const bool last = (t == nt - 2);
            const char* a1 = cA + (size_t)(t + 1) * kstep;
            const char* a2 = last ? nA : cA + (size_t)(t + 2) * kstep; const char* b2 = last ? nB : cB + (size_t)(t + 2) * kstep;
            const char* a3 = a2 + kstep; const char* b3 = b2 + kstep;
            if (last && has_next) S.a_ready(nxt);
            if constexpr (SP2) {
            PG8_LDB(B0, 0, 0); PG8_LDB(B1, 0, 1); PG8_SCHED; PG8_LDA(At, 0, 0); PG8_STAGE(PG8_SA(1, 1), a1 + hstep, voffA);
            PG8_WAIT_V(8); PG8_WAIT_L(0); PG8_BAR; PG8_MMA(0, 0, At, B0); PG8_MMA(0, 1, At, B1); PG8_BAR; PG8_SCHED;
            PG8_LDA(At, 0, 1); PG8_STAGE(PG8_SB(0, 0), b2, voffB); PG8_STAGE(PG8_SB(0, 1), b2 + hstep, voffB); PG8_STAGE(PG8_SA(0, 0), a2, voffA);
            PG8_WAIT_V(8); PG8_WAIT_L(0); PG8_BAR; PG8_MMA(1, 0, At, B0); PG8_MMA(1, 1, At, B1); PG8_BAR; PG8_SCHED;
            PG8_LDB(B0, 1, 0); PG8_LDB(B1, 1, 1); PG8_SCHED; PG8_LDA(At, 1, 0); PG8_STAGE(PG8_SA(0, 1), a2 + hstep, voffA);
            PG8_WAIT_V(8); PG8_WAIT_L(0); PG8_BAR; PG8_MMA(0, 0, At, B0); PG8_MMA(0, 1, At, B1); PG8_BAR; PG8_SCHED;
            PG8_LDA(At, 1, 1); PG8_STAGE(PG8_SB(1, 0), b3, voffB); PG8_STAGE(PG8_SB(1, 1), b3 + hstep, voffB); PG8_STAGE(PG8_SA(1, 0), a3, voffA);
            PG8_WAIT_V(8); PG8_WAIT_L(0); PG8_BAR; PG8_MMA(1, 0, At, B0); PG8_MMA(1, 1, At, B1); PG8_BAR; PG8_SCHED;
            } else {
            PG8_LDB(B0, 0, 0); PG8_SCHED; PG8_LDA(At, 0, 0); PG8_STAGE(PG8_SA(1, 1), a1 + hstep, voffA);
            PG8_WAIT_L(8); PG8_BAR; PG8_WAIT_L(0); PG8_MMA(0, 0, At, B0); PG8_BAR; PG8_SCHED;
            PG8_LDB(B1, 0, 1); PG8_STAGE(PG8_SB(0, 0), b2, voffB);
            PG8_BAR; PG8_WAIT_L(0); PG8_MMA(0, 1, At, B1); PG8_BAR;
            PG8_LDA(At, 0, 1); PG8_STAGE(PG8_SA(0, 0), a2, voffA);
            PG8_BAR; PG8_WAIT_L(0); PG8_MMA(1, 0, At, B0); PG8_BAR; PG8_SCHED;
            PG8_STAGE(PG8_SB(0, 1), b2 + hstep, voffB);
            PG8_WAIT_V(6); PG8_BAR; PG8_MMA(1, 1, At, B1); PG8_BAR;
            PG8_LDB(B0, 1, 0); PG8_SCHED; PG8_LDA(At, 1, 0); PG8_STAGE(PG8_SA(0, 1), a2 + hstep, voffA);
            PG8_WAIT_L(8); PG8_BAR; PG8_WAIT_L(0); PG8_MMA(0, 0, At, B0); PG8_BAR; PG8_SCHED;
            PG8_LDB(B1, 1, 1); PG8_STAGE(PG8_SB(1, 0), b3, voffB);
            PG8_BAR; PG8_WAIT_L(0); PG8_MMA(0, 1, At, B1); PG8_BAR;
            PG8_LDA(At, 1, 1); PG8_STAGE(PG8_SA(1, 0), a3, voffA);
            PG8_BAR; PG8_WAIT_L(0); PG8_MMA(1, 0, At, B0); PG8_BAR; PG8_SCHED;
            PG8_STAGE(PG8_SB(1, 1), b3 + hstep, voffB);
            PG8_WAIT_V(6); PG8_BAR; PG8_MMA(1, 1, At, B1); PG8_BAR;
            }
        }
        if constexpr (ALIGN_EPI) { if (wr == 0) PG8_BAR; }
        if constexpr (!Epi::AFTER_DRAIN) { E(acc, cur, wr, wc, fr, fq); S.done(cur); }
        if (!has_next) break;
#pragma unroll
        for (int a = 0; a < 2; ++a)
#pragma unroll
            for (int b = 0; b < 2; ++b)
#pragma unroll
                for (int m = 0; m < 4; ++m)
#pragma unroll
                    for (int n = 0; n < 2; ++n) acc[a][b][m][n] = (f32x4){0.f, 0.f, 0.f, 0.f};
        cur = nxt; cA = nA; cB = nB; ++ui;
        if constexpr (ALIGN_EPI) { if (wr == 1) PG8_BAR; }
    }
    PG8_WAIT_V(0);
    if constexpr (!ALIGN_EPI) { if (wr == 0) PG8_BAR; }
    PG8_BAR;
    if constexpr (Epi::AFTER_DRAIN) { E.fused(acc, cur, wr, wc, fr, fq, lds, wid, lane); S.done(cur); }
#undef PG8_SA
#undef PG8_SB
#undef PG8_STAGE
#undef PG8_LDA
#undef PG8_LDB
#undef PG8_MMA
#undef PG8_WAIT_V
#undef PG8_WAIT_L
#undef PG8_BAR
#undef PG8_SCHED
}
}

constexpr int NWAVES = 8;
constexpr int NWG = 256;
constexpr int BATCH = 2, T = 4096, DM = 4096, DEPTH = 2, M = BATCH * T, FF = 4 * DM;
constexpr int NIN_ORIG = 10976, NIN = 11008;
constexpr int C_RQ = 0, C_RK = 512, C_RV = 1024, C_RG = 2048, C_DQ = 3072, C_DK = 4608, C_DV = 5120, C_IQ = 5632, C_IK = 9728, C_IW = 9856,
              C_KR = 9888, C_PAD = 9952, C_CQ = 9984, C_CKV = 10752;
constexpr int O_CQ = 9888, O_CKV = 10656, O_KR = 10912;
constexpr int QL = 768, KVL = 256, NUQ = 2304, NUKV = 3072;
constexpr int MIXW = 4096, MIX_RET = 0, MIX_DSA = 1024, MIX_MLA = 2560;
constexpr float NORM_EPS = 1e-6f;
constexpr int TOPK = 256;

constexpr size_t MiB = 1u << 20;
constexpr size_t WS_CTL = 0, CTL_ZERO_BYTES = 1 * MiB;
constexpr size_t WS_TABA = 1 * MiB;
constexpr size_t WS_TABB = 2 * MiB;
constexpr size_t WS_W = 4 * MiB;
constexpr size_t SZ_WIN = (size_t)NIN * DM * 2, SZ_WUQ = (size_t)NUQ * QL * 2, SZ_WUKV = (size_t)NUKV * KVL * 2, SZ_WO = (size_t)DM * MIXW * 2, SZ_WUP = (size_t)FF * DM * 2, SZ_WDN = (size_t)DM * FF * 2;
constexpr size_t OFF_WIN = 0, OFF_WUQ = OFF_WIN + SZ_WIN, OFF_WUKV = OFF_WUQ + SZ_WUQ, OFF_WO = OFF_WUKV + SZ_WUKV, OFF_WUP = OFF_WO + SZ_WO, OFF_WDN = OFF_WUP + SZ_WUP, SZ_WLAYER = OFF_WDN + SZ_WDN;
constexpr size_t WS_H = WS_W + 2 * SZ_WLAYER;
constexpr size_t WS_U = WS_H + (size_t)M * DM * 4;
constexpr size_t WS_PROJ = WS_U + (size_t)M * DM * 2;
constexpr size_t WS_CQN = WS_PROJ + (size_t)M * NIN * 2;
constexpr size_t WS_CKVN = WS_CQN + (size_t)M * QL * 2;
constexpr size_t WS_QMLA = WS_CKVN + (size_t)M * KVL * 2;
constexpr size_t WS_KVMLA = WS_QMLA + (size_t)M * NUQ * 2;
constexpr size_t WS_MIX = WS_KVMLA + (size_t)M * NUKV * 2;
constexpr size_t WS_HID = WS_MIX + (size_t)M * MIXW * 2;
constexpr size_t WS_SEL = WS_HID + (size_t)M * FF * 2;
constexpr size_t WS_ISC = WS_SEL + (size_t)M * TOPK * 4;
constexpr size_t WS_DKC = WS_ISC + (size_t)M * T * 4;
constexpr size_t WS_DVC = WS_DKC + (size_t)M * 512 * 2;
constexpr size_t WS_IKC = WS_DVC + (size_t)M * 512 * 2;
constexpr size_t WS_BU = WS_IKC + (size_t)M * 128 * 2;
constexpr size_t WS_END = WS_BU + (size_t)BATCH * 8 * 16 * 64 * 128 * 4;
static_assert(SZ_WLAYER % 256 == 0 && WS_H % 256 == 0 && WS_PROJ % 256 == 0 && WS_CQN % 256 == 0 && WS_QMLA % 256 == 0 && WS_SEL % 256 == 0, "alignment");

constexpr int CW_TMO = 0, CW_CODE = 1, CW_BAR = 4096;
constexpr int CW_ROWSS = 65536;

constexpr int RING_OFF = 0, RING_BYTES = 131072;
constexpr int LDSCTL_OFF = RING_BYTES, MISC_OFF = LDSCTL_OFF + 320;
constexpr int LDS_BYTES = 163840;
constexpr int XTRA_OFF = RING_BYTES + 1024, XTRA_WAVE = 3968;

#define GAS __attribute__((address_space(1)))
#define LAS __attribute__((address_space(3)))
typedef unsigned short bf16;
typedef unsigned v4u __attribute__((ext_vector_type(4)));
typedef unsigned v2u __attribute__((ext_vector_type(2)));
typedef float f32x4 __attribute__((ext_vector_type(4)));
typedef float f32x2 __attribute__((ext_vector_type(2)));
typedef GAS unsigned gu32;
#define RLX_AGENT __ATOMIC_RELAXED, __HIP_MEMORY_SCOPE_AGENT
#define LDS_WAIT() asm volatile("s_waitcnt lgkmcnt(0)" ::: "memory")
#define VM_WAIT() asm volatile("s_waitcnt vmcnt(0)" ::: "memory")
__device__ __forceinline__ unsigned f2bf(float f) { unsigned u = __builtin_bit_cast(unsigned, f); return (u + 0x7fffu + ((u >> 16) & 1u)) >> 16; }
__device__ __forceinline__ unsigned pk2(float lo, float hi) { return f2bf(lo) | (f2bf(hi) << 16); }
__device__ __forceinline__ float bf2f(unsigned short b) { return __builtin_bit_cast(float, (unsigned)b << 16); }
__device__ __forceinline__ float bflo(unsigned w) { return __builtin_bit_cast(float, w << 16); }
__device__ __forceinline__ float bfhi(unsigned w) { return __builtin_bit_cast(float, w & 0xffff0000u); }
__device__ __forceinline__ float wave_sum(float v) {
#pragma unroll
    for (int o = 1; o < 64; o <<= 1) v += __shfl_xor(v, o);
    return v;
}
__device__ __forceinline__ float wave_max(float v) {
#pragma unroll
    for (int o = 1; o < 64; o <<= 1) v = fmaxf(v, __shfl_xor(v, o));
    return v;
}
__device__ __forceinline__ float rdlane(float v, int l) { return __builtin_bit_cast(float, __builtin_amdgcn_readlane(__builtin_bit_cast(int, v), l)); }

#define XB_TMO      128
#define XB_XCNT(j)  (256  + 64 * (j))
#define XB_XSUB(j)  (1280 + 64 * (j))
#define XB_XGEN(j)  (2304 + 64 * (j))
#define XB_TOP      3328
#define XB_TOPGEN   3392
#define XCD_BAR_WORDS 3456
#define XB_SPIN_CAP (1u << 22)

__device__ __forceinline__ unsigned xb_ld(unsigned* p)              { return __hip_atomic_load(p, __ATOMIC_RELAXED, __HIP_MEMORY_SCOPE_AGENT); }
__device__ __forceinline__ unsigned xb_add(unsigned* p, unsigned v) { return __hip_atomic_fetch_add(p, v, __ATOMIC_RELAXED, __HIP_MEMORY_SCOPE_AGENT); }
__device__ __forceinline__ unsigned xb_xcc_id() { return (unsigned)__builtin_amdgcn_s_getreg((3 << 11) | 20) & 0xFu; }
#define XB_SPIN(cond, bar) do { unsigned _sp = 0; while (cond) { __builtin_amdgcn_s_sleep(1); \
    if ((++_sp & 255u) == 0u) { if (xb_ld(&(bar)[XB_TMO])) break; if (_sp > XB_SPIN_CAP) { atomicAdd(&(bar)[XB_TMO], 1u); break; } } } } while (0)

struct XcdBarrier {
    unsigned* bar; unsigned x;
    volatile LAS unsigned* st;
};

__device__ __forceinline__ XcdBarrier xcd_barrier_post(unsigned* bar, volatile LAS unsigned* st) {
    XcdBarrier b; b.bar = bar; b.x = xb_xcc_id(); b.st = st;
    if (threadIdx.x == 0) (void)xb_add(&bar[XB_XCNT(b.x)], 1u);
    return b;
}
__device__ __forceinline__ void xcd_barrier_complete(unsigned* bar, unsigned x, unsigned& nloc, unsigned& nx) {
    const unsigned G = 256u;
    unsigned sum, cnt, mine, sp = 0u;
    for (;;) {
        sum = 0u; cnt = 0u; mine = 0u;
#pragma unroll
        for (unsigned j = 0; j < 16; ++j) { const unsigned c = xb_ld(&bar[XB_XCNT(j)]); sum += c; cnt += (c > 0u) ? 1u : 0u; mine = (j == x) ? c : mine; }
        if (sum == G) break;
        __builtin_amdgcn_s_sleep(1);
        if ((++sp & 255u) == 0u) { if (xb_ld(&bar[XB_TMO])) break; if (sp > XB_SPIN_CAP) { atomicAdd(&bar[XB_TMO], 1u); break; } }
    }
    nloc = mine > 0u ? mine : 1u; nx = cnt > 0u ? cnt : 1u;
}

__device__ __forceinline__ void xcd_barrier(const XcdBarrier& b, const int tid) {
    asm volatile("s_waitcnt vmcnt(0)" ::: "memory");
    __syncthreads();
    if (tid == 0) {
        unsigned* bar = b.bar;
        __builtin_amdgcn_s_waitcnt(0);
        unsigned nloc = b.st[0], nx = b.st[1];
        if (nloc == 0u) { xcd_barrier_complete(bar, b.x, nloc, nx); b.st[0] = nloc; b.st[1] = nx; }
        const unsigned old = xb_add(&bar[XB_XSUB(b.x)], 1u);
        const unsigned gen = old / nloc;
        if (old + 1u == (gen + 1u) * nloc) {
            __builtin_amdgcn_fence(__ATOMIC_RELEASE, "agent");
            asm volatile("s_waitcnt vmcnt(0)" ::: "memory");
            const unsigned og = xb_add(&bar[XB_TOP], 1u);
            const unsigned tg = og / nx;
            if (og + 1u == (tg + 1u) * nx) xb_add(&bar[XB_TOPGEN], 1u);
            else XB_SPIN(xb_ld(&bar[XB_TOPGEN]) == tg, bar);
            __builtin_amdgcn_fence(__ATOMIC_ACQUIRE, "agent");
            xb_add(&bar[XB_XGEN(b.x)], 1u);
            asm volatile("s_waitcnt vmcnt(0)" ::: "memory");
        } else {
            XB_SPIN(xb_ld(&bar[XB_XGEN(b.x)]) == gen, bar);
            __builtin_amdgcn_fence(__ATOMIC_ACQUIRE, "agent");
            asm volatile("s_waitcnt vmcnt(0)" ::: "memory");
        }
    }
    __syncthreads();
}


__device__ __forceinline__ int lane_now() { int l; asm volatile("v_mbcnt_lo_u32_b32 %0, -1, 0\n\tv_mbcnt_hi_u32_b32 %0, -1, %0" : "=v"(l)); return l; }
__device__ __forceinline__ int tid_now(int wave_s) { return wave_s * 64 + lane_now(); }
template <int OFF> __device__ __forceinline__ unsigned long long karg_u64() {
    unsigned long long v; const unsigned long long ka = (unsigned long long)__builtin_amdgcn_kernarg_segment_ptr();
    asm volatile("s_load_dwordx2 %0, %1, %2\n\ts_waitcnt lgkmcnt(0)" : "=s"(v) : "s"(ka), "i"(OFF) : "memory");
    return v;
}
#define KA_IN(i) ((const float*)(const GAS float*)karg_u64<8 * (i)>())
#define KA_OUT() ((float*)(GAS float*)karg_u64<96>())
#define KA_WS() ((unsigned char*)(GAS unsigned char*)karg_u64<104>())
struct Frame {
    LAS unsigned char* lds;
    unsigned char* ws;
    int lane, wave, gw, NGW;
};
__device__ __forceinline__ Frame make_frame(LAS unsigned char* lds, int wave_s) {
    Frame F; F.lds = lds; F.ws = KA_WS(); F.lane = lane_now(); F.wave = wave_s;
    F.gw = blockIdx.x * NWAVES + F.wave; F.NGW = NWG * NWAVES; return F;
}

struct TItem { f32x4 r[8]; f32x4 g[2]; };
__device__ __forceinline__ unsigned cvtpk_t(float lo, float hi) { typedef float f2_t __attribute__((ext_vector_type(2))); typedef __bf16 b2_t __attribute__((ext_vector_type(2))); f2_t v = {lo, hi}; b2_t b = __builtin_convertvector(v, b2_t); return __builtin_bit_cast(unsigned, b); }
__device__ __forceinline__ void titem_load(TItem& t, const float* W, int ldw, int c0, int k0, int lane, const float* gain) {
    const int kr = lane >> 3, c4 = lane & 7;
#pragma unroll
    for (int i = 0; i < 8; ++i) t.r[i] = __builtin_nontemporal_load((const GAS f32x4*)(W + (size_t)(k0 + 8 * kr + i) * ldw + c0 + 4 * c4));
    if (gain) { t.g[0] = *(const GAS f32x4*)(gain + k0 + 8 * kr); t.g[1] = *(const GAS f32x4*)(gain + k0 + 8 * kr + 4); }
}
__device__ __forceinline__ void titem_store(const TItem& t, int k0, bf16* WT, int K, int r0, LAS float* scr, int lane, bool has_gain) {
    const int kr = lane >> 3, c4 = lane & 7; (void)scr;
    GAS v4u* o = (GAS v4u*)(WT + (size_t)(r0 + 4 * c4) * K + k0 + 8 * kr);
#pragma unroll
    for (int e = 0; e < 4; ++e) {
        v4u w;
        if (has_gain) { w.x = cvtpk_t(t.r[0][e] * t.g[0].x, t.r[1][e] * t.g[0].y); w.y = cvtpk_t(t.r[2][e] * t.g[0].z, t.r[3][e] * t.g[0].w);
                        w.z = cvtpk_t(t.r[4][e] * t.g[1].x, t.r[5][e] * t.g[1].y); w.w = cvtpk_t(t.r[6][e] * t.g[1].z, t.r[7][e] * t.g[1].w); }
        else { w.x = cvtpk_t(t.r[0][e], t.r[1][e]); w.y = cvtpk_t(t.r[2][e], t.r[3][e]); w.z = cvtpk_t(t.r[4][e], t.r[5][e]); w.w = cvtpk_t(t.r[6][e], t.r[7][e]); }
        *(GAS v4u*)((GAS unsigned char*)o + (size_t)e * K * 2) = w; }
}
template <int NIF = 3>
__device__ __forceinline__ void transpose_seg(Frame& F, long& base, const float* W, int ldw, int K, int c0, int ncols, bf16* WT, int r0, LAS float* scr, const float* gain = nullptr) {
    const int nblk = ncols / 32, nit = (K / 64) * nblk;
    long first = ((long)__builtin_amdgcn_readfirstlane(F.gw) - base) % F.NGW; if (first < 0) first += F.NGW;
    TItem t[NIF]; const long st = F.NGW; long it[NIF];
#pragma unroll
    for (int q = 0; q < NIF; ++q) { it[q] = first + q * st; if (it[q] < nit) titem_load(t[q], W, ldw, c0 + 32 * (int)(it[q] % nblk), 64 * (int)(it[q] / nblk), F.lane, gain); }
    while (it[0] < nit) {
#pragma unroll
        for (int q = 0; q < NIF; ++q) if (it[q] < nit) {
            titem_store(t[q], 64 * (int)(it[q] / nblk), WT, K, r0 + 32 * (int)(it[q] % nblk), scr, F.lane, gain != nullptr); it[q] += NIF * st;
            if (it[q] < nit) titem_load(t[q], W, ldw, c0 + 32 * (int)(it[q] % nblk), 64 * (int)(it[q] / nblk), F.lane, gain); }
    }
    base += nit;
}
__device__ __forceinline__ void rms_row_to_f32(const float* xrow, const float* g, float* orow, int lane) {
    const GAS f32x4* xr = (const GAS f32x4*)xrow + lane; const GAS f32x4* gr = (const GAS f32x4*)g + lane;
    f32x4 v[16]; float s = 0.f;
#pragma unroll
    for (int j = 0; j < 16; ++j) { v[j] = __builtin_nontemporal_load(xr + 64 * j); s += (v[j].x * v[j].x + v[j].y * v[j].y) + (v[j].z * v[j].z + v[j].w * v[j].w); }
    const float rstd = 1.f / sqrtf(wave_sum(s) * (1.f / DM) + NORM_EPS);
    GAS f32x4* o = (GAS f32x4*)orow + lane;
#pragma unroll
    for (int j = 0; j < 16; ++j) { const f32x4 gg = gr[64 * j]; __builtin_nontemporal_store((v[j] * rstd) * gg, o + 64 * j); }
}

__host__ __device__ constexpr int inproj_gemm_wgs(int G) { const int nwg = (M / 256) * (NIN / 256), rounds = (nwg + G - 1) / G; return (nwg + rounds - 1) / rounds; }
__device__ __forceinline__ void side_convert(LAS unsigned char* lds, const int wave_s, int l, int rank, int H) {
    Frame F = make_frame(lds, wave_s); F.gw = rank * NWAVES + F.wave; F.NGW = H * NWAVES;
    LAS float* scr = (LAS float*)(F.lds + RING_OFF + F.wave * 16384);
    unsigned char* wl = F.ws + WS_W + (size_t)l * SZ_WLAYER; const float* g_mlp = KA_IN(8) + (size_t)l * DM; long base = 0;
    transpose_seg(F, base, KA_IN(7) + (size_t)l * MIXW * DM, DM, MIXW, 0, DM, (bf16*)(wl + OFF_WO), 0, scr);
    transpose_seg(F, base, KA_IN(9) + (size_t)l * DM * FF, FF, DM, 0, FF, (bf16*)(wl + OFF_WUP), 0, scr, g_mlp);
}
template <int NIF>
__device__ __forceinline__ void convert_front(Frame& F, long& base, int l) {
    unsigned char* wl = F.ws + WS_W + (size_t)l * SZ_WLAYER; LAS float* scr = nullptr;
    const float* w_in = KA_IN(2) + (size_t)l * DM * NIN_ORIG; const float* g_attn = KA_IN(1) + (size_t)l * DM;
    bf16* WinT = (bf16*)(wl + OFF_WIN);
    transpose_seg<NIF>(F, base, w_in, NIN_ORIG, DM, 0, O_CQ, WinT, 0, scr, g_attn);
    transpose_seg<NIF>(F, base, w_in, NIN_ORIG, DM, O_CQ, QL + KVL, WinT, C_CQ, scr, g_attn);
    transpose_seg<NIF>(F, base, w_in, NIN_ORIG, DM, O_KR, 64, WinT, C_KR, scr, g_attn);
    transpose_seg<NIF>(F, base, KA_IN(5) + (size_t)l * QL * NUQ, NUQ, QL, 0, NUQ, (bf16*)(wl + OFF_WUQ), 0, scr);
    transpose_seg<NIF>(F, base, KA_IN(6) + (size_t)l * KVL * NUKV, NUKV, KVL, 0, NUKV, (bf16*)(wl + OFF_WUKV), 0, scr);
    { unsigned z = 0u; asm volatile("" : "+v"(z));
      for (int i = F.gw * 64 + F.lane; i < 32 * DM * 2 / 16; i += F.NGW * 64) ((GAS v4u*)(WinT + (size_t)C_PAD * DM))[i] = (v4u){z, z, z, z}; }
}
constexpr int ATT_CONV = 128;
__device__ __forceinline__ void wdn_convert(LAS unsigned char* lds, const int wave_s, int l, int rank) {
    Frame F = make_frame(lds, wave_s); F.gw = rank * NWAVES + F.wave; F.NGW = ATT_CONV * NWAVES;
    unsigned char* wl = F.ws + WS_W + (size_t)l * SZ_WLAYER; long base = 0;
    transpose_seg<5>(F, base, KA_IN(10) + (size_t)l * FF * DM, DM, FF, 0, DM, (bf16*)(wl + OFF_WDN), 0, (LAS float*)nullptr);
    if (l + 1 < DEPTH) convert_front<5>(F, base, l + 1);
}
__device__ __forceinline__ void p0_prologue(LAS unsigned char* lds, const int wave_s) {
    Frame F = make_frame(lds, wave_s);
    LAS float* scr = (LAS float*)(F.lds + RING_OFF + F.wave * 16384);
    long base = 0;
    convert_front<3>(F, base, 0);
    {
        float2* tabA = (float2*)(F.ws + WS_TABA); float2* tabB = (float2*)(F.ws + WS_TABB);
        const int gt = F.gw * 64 + F.lane, NT = F.NGW * 64;
        for (int i = gt; i < T * 32; i += NT) { const int t = i >> 5, k = i & 31; const float inv = expf((-9.210340371976184f * (float)k) * (2.0f / 64.0f)); const float ang = (float)t * inv; tabA[i] = make_float2(cosf(ang), sinf(ang)); }
        for (int i = gt; i < T * 16; i += NT) { const int t = i >> 4, k = i & 15; const float inv = expf((-13.122363377404328f * (float)k) * (2.0f / 32.0f)); const float ang = (float)t * inv; tabB[i] = make_float2(cosf(ang), sinf(ang)); }
    }
    { const float* x = KA_IN(0); float* rss = (float*)(F.ws + WS_CTL) + CW_ROWSS;
      for (int m = F.gw; m < M; m += F.NGW) {
          const GAS f32x4* xr = (const GAS f32x4*)(x + (size_t)m * DM) + F.lane; GAS v2u* o8 = (GAS v2u*)((bf16*)(F.ws + WS_U) + (size_t)m * DM) + F.lane; float sq = 0.f;
#pragma unroll
          for (int j = 0; j < 16; ++j) { const f32x4 v = __builtin_nontemporal_load(xr + 64 * j); sq += (v.x * v.x + v.y * v.y) + (v.z * v.z + v.w * v.w); v2u o; o.x = pk2(v.x, v.y); o.y = pk2(v.z, v.w); o8[64 * j] = o; }
          sq = wave_sum(sq); if (F.lane == 0) rss[m] = sq; } }
}

__device__ __forceinline__ v4u rope_chunk(v4u own, v4u par, const float2* tab8, float sg, float scale) {
    const GAS f32x4* tp = (const GAS f32x4*)tab8; unsigned ow[4] = {own.x, own.y, own.z, own.w}, pw[4] = {par.x, par.y, par.z, par.w};
#pragma unroll
    for (int jj = 0; jj < 4; ++jj) { const f32x4 cs = tp[jj];
        ow[jj] = pk2((bflo(ow[jj]) * cs.x + sg * bflo(pw[jj]) * cs.y) * scale, (bfhi(ow[jj]) * cs.z + sg * bfhi(pw[jj]) * cs.w) * scale); }
    return (v4u){ow[0], ow[1], ow[2], ow[3]};
}
__device__ __forceinline__ void prep_phase(LAS unsigned char* lds, const int wave_s, int layer) {
    Frame F = make_frame(lds, wave_s);
    bf16* proj = (bf16*)(F.ws + WS_PROJ); bf16* cqn = (bf16*)(F.ws + WS_CQN); bf16* ckvn = (bf16*)(F.ws + WS_CKVN);
    const float2* tabA = (const float2*)(F.ws + WS_TABA); const float2* tabB = (const float2*)(F.ws + WS_TABB);
    const float* gq = KA_IN(3) + (size_t)layer * QL; const float* gkv = KA_IN(4) + (size_t)layer * KVL;
    const int lane = F.lane;
    for (int m = F.gw; m < M; m += F.NGW) {
        const int t = m & (T - 1), bb = m / T; bf16* row = proj + (size_t)m * NIN; const float2* ta = tabA + t * 32; const float2* tb = tabB + t * 16;
        GAS v4u* rq = (GAS v4u*)(row + C_RQ); GAS v4u* rk = (GAS v4u*)(row + C_RK); GAS v4u* kr = (GAS v4u*)(row + C_KR);
        const v4u rq_o = rq[lane], rq_p = rq[lane ^ 4], rk_o = rk[lane], rk_p = rk[lane ^ 4];
        const int dh = lane >> 2, dc = lane & 3;
        GAS v4u* dqp = (GAS v4u*)(row + C_DQ + (lane < 48 ? dh : 0) * 128);
        const v4u dq_o = dqp[dc], dq_p = dqp[dc ^ 2];
        GAS v4u* iq0 = (GAS v4u*)(row + C_IQ + dh * 128); GAS v4u* iq1 = (GAS v4u*)(row + C_IQ + (16 + dh) * 128);
        const v4u i0_o = iq0[dc], i0_p = iq0[dc ^ 2], i1_o = iq1[dc], i1_p = iq1[dc ^ 2];
        const v4u kr_o = kr[lane & 7], kr_p = kr[(lane & 7) ^ 4];
        const int n = lane >> 4, c = lane & 15;
        const GAS v4u* dks = (const GAS v4u*)(row + C_DK + n * 128); const GAS v4u* iks = (const GAS v4u*)(row + C_IK);
        v4u dk_o = dks[c]; const v4u dk_p = dks[c < 4 ? (c ^ 2) : c]; v4u ik_o = iks[c]; const v4u ik_p = iks[c < 4 ? (c ^ 2) : c];
        const v4u dv_o = ((const GAS v4u*)(row + C_DV + n * 128))[c];
        const GAS v4u* cqs = (const GAS v4u*)(row + C_CQ); const v4u cq0 = cqs[lane], cq1 = cqs[64 + (lane & 31)]; const v4u ckv0 = ((const GAS v4u*)(row + C_CKV))[lane & 31];
        { const int c8 = lane & 7; const float sg = (c8 < 4) ? -1.f : 1.f; const float2* tq = ta + (c8 & 3) * 8;
          rq[lane] = rope_chunk(rq_o, rq_p, tq, sg, 1.f); rk[lane] = rope_chunk(rk_o, rk_p, tq, sg, 0.125f);
          if (lane < 8) kr[lane] = rope_chunk(kr_o, kr_p, tq, sg, 1.f); }
        { const float sg = (dc < 2) ? -1.f : 1.f; const float2* tq = tb + (dc & 1) * 8;
          if (lane < 48) dqp[dc] = rope_chunk(dq_o, dq_p, tq, sg, 1.f);
          iq0[dc] = rope_chunk(i0_o, i0_p, tq, sg, 1.f); iq1[dc] = rope_chunk(i1_o, i1_p, tq, sg, 1.f); }
        { if (c < 4) { const float sg = (c < 2) ? -1.f : 1.f; const float2* tq = tb + (c & 1) * 8; dk_o = rope_chunk(dk_o, dk_p, tq, sg, 1.f); ik_o = rope_chunk(ik_o, ik_p, tq, sg, 1.f); }
          const size_t di = (((size_t)(bb * 4 + n)) * T + t) * 128 + c * 8;
          *(GAS v4u*)((bf16*)(F.ws + WS_DKC) + di) = dk_o;
          *(GAS v4u*)((bf16*)(F.ws + WS_DVC) + di) = dv_o;
          if (lane < 16) *(GAS v4u*)((bf16*)(F.ws + WS_IKC) + (size_t)m * 128 + c * 8) = ik_o; }
        { const unsigned w0[4] = {cq0.x, cq0.y, cq0.z, cq0.w}, w1[4] = {cq1.x, cq1.y, cq1.z, cq1.w}; float sq = 0.f, sq1 = 0.f;
#pragma unroll
          for (int jj = 0; jj < 4; ++jj) { sq += bflo(w0[jj]) * bflo(w0[jj]) + bfhi(w0[jj]) * bfhi(w0[jj]); sq1 += bflo(w1[jj]) * bflo(w1[jj]) + bfhi(w1[jj]) * bfhi(w1[jj]); }
          if (lane < 32) sq += sq1;
          const float rstd = 1.f / sqrtf(wave_sum(sq) * (1.f / QL) + NORM_EPS);
          { const GAS f32x4* gp = (const GAS f32x4*)(gq + 8 * lane); const f32x4 ga = gp[0], gb = gp[1]; v4u o;
            o.x = pk2(bflo(w0[0]) * rstd * ga.x, bfhi(w0[0]) * rstd * ga.y); o.y = pk2(bflo(w0[1]) * rstd * ga.z, bfhi(w0[1]) * rstd * ga.w);
            o.z = pk2(bflo(w0[2]) * rstd * gb.x, bfhi(w0[2]) * rstd * gb.y); o.w = pk2(bflo(w0[3]) * rstd * gb.z, bfhi(w0[3]) * rstd * gb.w);
            *(GAS v4u*)(cqn + (size_t)m * QL + 8 * lane) = o; }
          if (lane < 32) { const GAS f32x4* gp = (const GAS f32x4*)(gq + 512 + 8 * lane); const f32x4 ga = gp[0], gb = gp[1]; v4u o;
            o.x = pk2(bflo(w1[0]) * rstd * ga.x, bfhi(w1[0]) * rstd * ga.y); o.y = pk2(bflo(w1[1]) * rstd * ga.z, bfhi(w1[1]) * rstd * ga.w);
            o.z = pk2(bflo(w1[2]) * rstd * gb.x, bfhi(w1[2]) * rstd * gb.y); o.w = pk2(bflo(w1[3]) * rstd * gb.z, bfhi(w1[3]) * rstd * gb.w);
            *(GAS v4u*)(cqn + (size_t)m * QL + 512 + 8 * lane) = o; } }
        { const unsigned w0[4] = {ckv0.x, ckv0.y, ckv0.z, ckv0.w}; float sq = 0.f;
#pragma unroll
          for (int jj = 0; jj < 4; ++jj) sq += bflo(w0[jj]) * bflo(w0[jj]) + bfhi(w0[jj]) * bfhi(w0[jj]);
          if (lane >= 32) sq = 0.f;
          const float rstd = 1.f / sqrtf(wave_sum(sq) * (1.f / KVL) + NORM_EPS);
          if (lane < 32) { const GAS f32x4* gp = (const GAS f32x4*)(gkv + 8 * lane); const f32x4 ga = gp[0], gb = gp[1]; v4u o;
            o.x = pk2(bflo(w0[0]) * rstd * ga.x, bfhi(w0[0]) * rstd * ga.y); o.y = pk2(bflo(w0[1]) * rstd * ga.z, bfhi(w0[1]) * rstd * ga.w);
            o.z = pk2(bflo(w0[2]) * rstd * gb.x, bfhi(w0[2]) * rstd * gb.y); o.w = pk2(bflo(w0[3]) * rstd * gb.z, bfhi(w0[3]) * rstd * gb.w);
            *(GAS v4u*)(ckvn + (size_t)m * KVL + 8 * lane) = o; } }
    }
}


__device__ __forceinline__ unsigned sortable(float f) { const unsigned u = __builtin_bit_cast(unsigned, f); return (u & 0x80000000u) ? ~u : (u | 0x80000000u); }
typedef short bf16x8 __attribute__((ext_vector_type(8)));
typedef short s16x4 __attribute__((ext_vector_type(4)));
typedef short v4i16_t __attribute__((ext_vector_type(4)));
typedef float f32x16 __attribute__((ext_vector_type(16)));
typedef float f32x2_t __attribute__((ext_vector_type(2))); typedef __bf16 bf16x2_t __attribute__((ext_vector_type(2)));
__device__ __forceinline__ unsigned cvtpk_s(float lo, float hi) { f32x2_t v = {lo, hi}; bf16x2_t b = __builtin_convertvector(v, bf16x2_t); return __builtin_bit_cast(unsigned, b); }
#define MFMA32(a, b, c) __builtin_amdgcn_mfma_f32_32x32x16_bf16((a), (b), (c), 0, 0, 0)
__device__ __forceinline__ int crow(int r, int hi) { return (r & 3) + 8 * (r >> 2) + 4 * hi; }
__device__ __forceinline__ s16x4 vtr(const LAS char* p) { return __builtin_bit_cast(s16x4, __builtin_amdgcn_ds_read_tr16_b64_v4i16((LAS v4i16_t*)p)); }
__device__ __forceinline__ bf16x8 pack8f(float a0, float a1, float a2, float a3, float a4, float a5, float a6, float a7) {
    v4u w; w.x = cvtpk_s(a0, a1); w.y = cvtpk_s(a2, a3); w.z = cvtpk_s(a4, a5); w.w = cvtpk_s(a6, a7); return __builtin_bit_cast(bf16x8, w);
}
constexpr int CW_QUEUE = 8192;
__device__ __forceinline__ unsigned* queue_word(unsigned char* ws, int layer, int k) { return (unsigned*)(ws + WS_CTL) + CW_QUEUE + (layer * 32 + k) * 64; }

template <int MODE> struct AttnCfg;
template <> struct AttnCfg<0> { static constexpr int NKS = 12, KROW = 384, KPW = 3; };
template <> struct AttnCfg<1> { static constexpr int NKS = 4, KROW = 128, KPW = 1; };
template <> struct AttnCfg<2> { static constexpr int NKS = 4, KROW = 128, KPW = 1; };
template <int MODE>
__device__ __forceinline__ void attn_unit(LAS unsigned char* lds, unsigned char* ws, int b, int h, int qb, int tid) {
    typedef AttnCfg<MODE> C;
    const int lane = tid & 63, wave = __builtin_amdgcn_readfirstlane(tid >> 6), r32 = lane & 31, hh = lane >> 5;
    const bf16* proj = (const bf16*)(ws + WS_PROJ); const bf16* qm = (const bf16*)(ws + WS_QMLA); const bf16* kvm = (const bf16*)(ws + WS_KVMLA); bf16* mix = (bf16*)(ws + WS_MIX);
    const int q0w = 256 * qb + 32 * wave, qabs = q0w + r32; const size_t mrow = (size_t)b * T + qabs;
    bf16x8 qf[C::NKS];
    if (MODE == 0) {
        const GAS v4u* qp = (const GAS v4u*)(qm + mrow * NUQ + h * 192);
        v4u raw[12];
#pragma unroll
        for (int ks = 0; ks < 12; ++ks) raw[ks] = qp[2 * ks + hh];
        unsigned char* wsl = ws; asm volatile("" : "+s"(wsl));
        const GAS f32x4* tp = (const GAS f32x4*)((const float2*)(wsl + WS_TABA) + qabs * 32);
#pragma unroll
        for (int ks = 8; ks < 10; ++ks) {
            unsigned x1w[4] = {raw[ks].x, raw[ks].y, raw[ks].z, raw[ks].w}, x2w[4] = {raw[ks + 2].x, raw[ks + 2].y, raw[ks + 2].z, raw[ks + 2].w};
            unsigned y1w[4], y2w[4];
#pragma unroll
            for (int jj = 0; jj < 4; ++jj) {
                const f32x4 cs = tp[(16 * (ks - 8) + 8 * hh) / 2 + jj];
                const float a1 = bflo(x1w[jj]), a2 = bflo(x2w[jj]), b1 = bfhi(x1w[jj]), b2 = bfhi(x2w[jj]);
                y1w[jj] = cvtpk_s(a1 * cs.x - a2 * cs.y, b1 * cs.z - b2 * cs.w);
                y2w[jj] = cvtpk_s(a2 * cs.x + a1 * cs.y, b2 * cs.z + b1 * cs.w);
            }
            raw[ks] = (v4u){y1w[0], y1w[1], y1w[2], y1w[3]}; raw[ks + 2] = (v4u){y2w[0], y2w[1], y2w[2], y2w[3]};
        }
#pragma unroll
        for (int ks = 0; ks < 12; ++ks) qf[ks] = __builtin_bit_cast(bf16x8, raw[ks]);
    } else if (MODE == 1) {
        const GAS v4u* qp = (const GAS v4u*)(proj + mrow * NIN + C_RQ + h * 64);
#pragma unroll
        for (int ks = 0; ks < C::NKS; ++ks) qf[ks] = __builtin_bit_cast(bf16x8, qp[2 * ks + hh]);
    } else {
        const int dsel = 32 * wave + r32;
#pragma unroll
        for (int ks = 0; ks < C::NKS; ++ks)
#pragma unroll
            for (int jj = 0; jj < 8; ++jj) qf[ks][jj] = (wave < 2 && 16 * ks + 8 * hh + jj == dsel) ? (short)0x3F80 : (short)0;
    }
    constexpr int KBYTES = 64 * C::KROW, BUFSZ = KBYTES + 16384;
    const size_t brow = (size_t)b * T;
    unsigned koffA[C::KPW]; bool kisA[C::KPW]; unsigned voffs[2];
#pragma unroll
    for (int i = 0; i < C::KPW; ++i) { const int o = (wave + 8 * i) * 1024 + lane * 16, row = o / C::KROW, pos = (o % C::KROW) / 16, c = (pos & ~7) | ((pos & 7) ^ ((row >> 1) & 7));
        if (MODE == 0) { kisA[i] = c < 16; koffA[i] = kisA[i] ? (unsigned)(row * 512 + c * 16) : (unsigned)(row * (NIN * 2) + (c - 16) * 16); }
        else { kisA[i] = true; koffA[i] = (unsigned)(row * (NIN * 2) + c * 16); } }
#pragma unroll
    for (int i = 0; i < 2; ++i) { const int row = 4 * (wave + 8 * i) + (lane >> 4), c = (lane & 15) ^ (4 * (row & 3)); voffs[i] = (unsigned)(row * (MODE == 0 ? 512 : NIN * 2) + c * 16); }
    const char* kbaseA = (MODE == 0) ? (const char*)(kvm + ((size_t)h * M + brow) * 256) : (const char*)(proj + brow * NIN + C_RK + h * 64);
    const char* kbaseB = (const char*)(proj + brow * NIN + C_KR);
    const char* vbase_ = (MODE == 0) ? (const char*)(kvm + ((size_t)h * M + brow) * 256 + 128) : (const char*)(proj + brow * NIN + C_RV + h * 128);
    auto issue = [&](int j, int boff) {
        const size_t stepA = (size_t)j * 64 * (MODE == 0 ? 512 : NIN * 2), stepB = (size_t)j * 64 * (NIN * 2);
#pragma unroll
        for (int i = 0; i < C::KPW; ++i) { const char* p = kisA[i] ? (kbaseA + stepA + koffA[i]) : (kbaseB + stepB + koffA[i]);
            __builtin_amdgcn_global_load_lds((const GAS unsigned*)p, (LAS unsigned*)(lds + boff + (wave + 8 * i) * 1024), 16, 0, 0); }
#pragma unroll
        for (int i = 0; i < 2; ++i) __builtin_amdgcn_global_load_lds((const GAS unsigned*)(vbase_ + stepA + voffs[i]), (LAS unsigned*)(lds + boff + KBYTES + (wave + 8 * i) * 1024), 16, 0, 0);
    };
    f32x16 o[4];
#pragma unroll
    for (int d = 0; d < 4; ++d)
#pragma unroll
        for (int i = 0; i < 16; ++i) o[d][i] = 0.f;
    float mrun = -1e30f, lrun = 0.f;
    constexpr float C2 = 0.07216878364870322f * 1.4426950408889634f;
    const float lg2 = (MODE != 0) ? log1pf(-exp2f(-5.f - (float)h)) * 1.4426950408889634f : 0.f;
    const int ntiles = 4 * (qb + 1), jlo = (MODE == 0) ? 0 : 4 * qb;
    const int trq = (lane & 15) >> 2, trp = lane & 3, trb = (lane >> 4) & 1;
    const int voff = (4 * hh + trq) * 256 + (2 * trb + (trp >> 1)) * 16 + (trp & 1) * 8;
    const int kt0 = hh ^ ((r32 >> 1) & 7);
    constexpr int ST_OFF = 3 * BUFSZ;
    if (MODE == 1 && qb > 0) {
        const int sd = tid >> 3, se = (tid & 7) * 16; float sa[16];
#pragma unroll
        for (int i = 0; i < 16; ++i) sa[i] = 0.f;
        const float* bu = (const float*)(ws + WS_BU) + ((size_t)((b * 8 + h) * 16) * 64 + sd) * 128 + se;
#pragma unroll 4
        for (int up = 0; up < qb; ++up) { const float wgt = __builtin_amdgcn_exp2f((float)(256 * (qb - 1 - up)) * lg2); const GAS f32x4* p4 = (const GAS f32x4*)(bu + (size_t)up * 64 * 128);
#pragma unroll
            for (int i = 0; i < 4; ++i) { const f32x4 v = p4[i]; sa[4 * i] = fmaf(wgt, v.x, sa[4 * i]); sa[4 * i + 1] = fmaf(wgt, v.y, sa[4 * i + 1]); sa[4 * i + 2] = fmaf(wgt, v.z, sa[4 * i + 2]); sa[4 * i + 3] = fmaf(wgt, v.w, sa[4 * i + 3]); } }
        LAS unsigned char* st = lds + ST_OFF + sd * 256; const int c0 = (tid & 7) * 2, sw = 4 * (sd & 3);
        *(LAS v4u*)(st + ((c0 ^ sw) << 4)) = (v4u){cvtpk_s(sa[0], sa[1]), cvtpk_s(sa[2], sa[3]), cvtpk_s(sa[4], sa[5]), cvtpk_s(sa[6], sa[7])};
        *(LAS v4u*)(st + (((c0 + 1) ^ sw) << 4)) = (v4u){cvtpk_s(sa[8], sa[9]), cvtpk_s(sa[10], sa[11]), cvtpk_s(sa[12], sa[13]), cvtpk_s(sa[14], sa[15])};
    }
    int b_cur = 0, b_nxt = BUFSZ, b_nn = 2 * BUFSZ;
    issue(jlo, b_cur); if (jlo + 1 < ntiles) issue(jlo + 1, b_nxt);
    constexpr int PW = C::KPW + 2;
    for (int j = jlo; j < ntiles; ++j) {
        if (j + 1 < ntiles) { if (PW == 5) asm volatile("s_waitcnt vmcnt(5) lgkmcnt(0)\n\ts_barrier" ::: "memory"); else asm volatile("s_waitcnt vmcnt(3) lgkmcnt(0)\n\ts_barrier" ::: "memory"); }
        else asm volatile("s_waitcnt vmcnt(0) lgkmcnt(0)\n\ts_barrier" ::: "memory");
        if (j + 2 < ntiles) issue(j + 2, b_nn);
        if ((MODE == 2) ? (wave < 2) : (64 * j <= q0w + 31)) {
            const LAS unsigned char* kb = lds + b_cur + r32 * C::KROW;
            const LAS unsigned char* vb = lds + b_cur + KBYTES + voff;
            f32x16 s0, s1;
#pragma unroll
            for (int i = 0; i < 16; ++i) { s0[i] = 0.f; s1[i] = 0.f; }
            { bf16x8 kfa[3], kfb[3];
#define AT_KREAD(ks_, sl_) do { const int kco_ = (((2 * (ks_)) & ~7) << 4) | ((((2 * (ks_)) & 7) ^ kt0) << 4); kfa[sl_] = *(const LAS bf16x8*)(kb + kco_); kfb[sl_] = *(const LAS bf16x8*)(kb + 32 * C::KROW + kco_); } while (0)
              AT_KREAD(0, 0); AT_KREAD(1, 1);
              __builtin_amdgcn_sched_barrier(0);
#pragma unroll
              for (int ks = 0; ks < C::NKS; ++ks) {
                  if (ks + 2 < C::NKS) AT_KREAD(ks + 2, (ks + 2) % 3);
                  s0 = MFMA32(kfa[ks % 3], qf[ks], s0); s1 = MFMA32(kfb[ks % 3], qf[ks], s1);
                  __builtin_amdgcn_sched_barrier(0);
              }
#undef AT_KREAD
            }
            const int dq = qabs - 64 * j - 4 * hh;
            bf16x8 pf[4];
            if (MODE == 0) {
                if (64 * j + 63 > q0w) {
#pragma unroll
                    for (int i = 0; i < 16; ++i) { const int c = (i & 3) + 8 * (i >> 2); if (c > dq) s0[i] = -__builtin_inff(); if (c + 32 > dq) s1[i] = -__builtin_inff(); }
                }
                float tmax = s0[0];
#pragma unroll
                for (int i = 1; i < 16; ++i) tmax = fmaxf(tmax, s0[i]);
#pragma unroll
                for (int i = 0; i < 16; ++i) tmax = fmaxf(tmax, s1[i]);
                tmax = fmaxf(tmax, __shfl_xor(tmax, 32));
                const float mnew = fmaxf(mrun, tmax); const float alpha = __builtin_amdgcn_exp2f((mrun - mnew) * C2); const bool grew = __builtin_amdgcn_ballot_w64(mnew > mrun) != 0ull; mrun = mnew;
                const float mc = -mnew * C2; float ps = 0.f;
#pragma unroll
                for (int i = 0; i < 16; ++i) { s0[i] = __builtin_amdgcn_exp2f(fmaf(s0[i], C2, mc)); s1[i] = __builtin_amdgcn_exp2f(fmaf(s1[i], C2, mc)); ps += s0[i] + s1[i]; }
                lrun = lrun * alpha + ps;
                if (grew) {
#pragma unroll
                for (int d = 0; d < 4; ++d)
#pragma unroll
                    for (int i = 0; i < 16; ++i) o[d][i] *= alpha; }
            } else {
                const int dqq = (MODE == 2) ? (256 * qb + 255 - 64 * j - 4 * hh) : dq;
#pragma unroll
                for (int i = 0; i < 16; ++i) { const int c = (i & 3) + 8 * (i >> 2);
                    const float w0 = (c <= dqq) ? __builtin_amdgcn_exp2f((float)(dqq - c) * lg2) : 0.f, w1 = (c + 32 <= dqq) ? __builtin_amdgcn_exp2f((float)(dqq - c - 32) * lg2) : 0.f;
                    s0[i] *= w0; s1[i] *= w1; }
            }
            pf[0] = pack8f(s0[0], s0[1], s0[2], s0[3], s0[4], s0[5], s0[6], s0[7]); pf[1] = pack8f(s0[8], s0[9], s0[10], s0[11], s0[12], s0[13], s0[14], s0[15]);
            pf[2] = pack8f(s1[0], s1[1], s1[2], s1[3], s1[4], s1[5], s1[6], s1[7]); pf[3] = pack8f(s1[8], s1[9], s1[10], s1[11], s1[12], s1[13], s1[14], s1[15]);
            { bf16x8 vfr[3];
#define AT_VREAD(ix_, sl_) do { const int s_ = (ix_) >> 2, d_ = (ix_) & 3; const s16x4 lo_ = vtr((const LAS char*)(vb + (16 * s_) * 256 + ((d_ ^ trq) << 6))), hi_ = vtr((const LAS char*)(vb + (16 * s_ + 8) * 256 + ((d_ ^ trq) << 6))); \
                                vfr[sl_] = __builtin_shufflevector(lo_, hi_, 0, 1, 2, 3, 4, 5, 6, 7); } while (0)
              AT_VREAD(0, 0); AT_VREAD(1, 1);
              __builtin_amdgcn_sched_barrier(0);
#pragma unroll
              for (int ix = 0; ix < 16; ++ix) {
                  if (ix + 2 < 16) AT_VREAD(ix + 2, (ix + 2) % 3);
                  o[ix & 3] = MFMA32(vfr[ix % 3], pf[ix >> 2], o[ix & 3]);
                  __builtin_amdgcn_sched_barrier(0);
              }
#undef AT_VREAD
            }
        }
        { const int t_ = b_cur; b_cur = b_nxt; b_nxt = b_nn; b_nn = t_; }
    }
    if (MODE == 1 && qb > 0) {
        const float dqv = __builtin_amdgcn_exp2f((float)(qabs - 256 * qb + 1) * lg2);
        const bf16* qrow = proj + mrow * NIN + C_RQ + h * 64 + 4 * hh;
        const LAS unsigned char* sb = lds + ST_OFF + voff;
#pragma unroll
        for (int s = 0; s < 4; ++s) {
            const v2u qlo = *(const GAS v2u*)(qrow + 16 * s), qhi = *(const GAS v2u*)(qrow + 16 * s + 8);
            const bf16x8 pq = pack8f(bflo(qlo.x) * dqv, bfhi(qlo.x) * dqv, bflo(qlo.y) * dqv, bfhi(qlo.y) * dqv, bflo(qhi.x) * dqv, bfhi(qhi.x) * dqv, bflo(qhi.y) * dqv, bfhi(qhi.y) * dqv);
#pragma unroll
            for (int d = 0; d < 4; ++d) {
                const s16x4 lo = vtr((const LAS char*)(sb + (16 * s) * 256 + ((d ^ trq) << 6))), hi = vtr((const LAS char*)(sb + (16 * s + 8) * 256 + ((d ^ trq) << 6)));
                const bf16x8 vf = __builtin_shufflevector(lo, hi, 0, 1, 2, 3, 4, 5, 6, 7);
                o[d] = MFMA32(vf, pq, o[d]);
            }
        }
    }
    if (MODE == 2) {
        if (wave < 2) { float* bo = (float*)(ws + WS_BU) + ((size_t)(((b * 8 + h) * 16 + qb) * 64 + 32 * wave + r32)) * 128 + 4 * hh;
#pragma unroll
            for (int d = 0; d < 4; ++d)
#pragma unroll
                for (int g = 0; g < 4; ++g) *(GAS f32x4*)(bo + 32 * d + 8 * g) = (f32x4){o[d][4 * g], o[d][4 * g + 1], o[d][4 * g + 2], o[d][4 * g + 3]}; }
        return;
    }
    if (MODE == 0) {
        const float lt = lrun + __shfl_xor(lrun, 32); const float il = 1.f / lt;
        bf16* orow = mix + mrow * MIXW + MIX_MLA + h * 128 + 4 * hh;
#pragma unroll
        for (int d = 0; d < 4; ++d)
#pragma unroll
            for (int g = 0; g < 4; ++g) { v2u w; w.x = cvtpk_s(o[d][4 * g] * il, o[d][4 * g + 1] * il); w.y = cvtpk_s(o[d][4 * g + 2] * il, o[d][4 * g + 3] * il);
                *(GAS v2u*)(orow + 32 * d + 8 * g) = w; }
    } else {
        float ss = 0.f;
#pragma unroll
        for (int d = 0; d < 4; ++d)
#pragma unroll
            for (int i = 0; i < 16; ++i) ss += o[d][i] * o[d][i];
        ss += __shfl_xor(ss, 32);
        const float rstd = 1.f / sqrtf(ss * (1.f / 128.f) + NORM_EPS);
        const bf16* grow = proj + mrow * NIN + C_RG + h * 128 + 4 * hh; bf16* orow = mix + mrow * MIXW + MIX_RET + h * 128 + 4 * hh;
#pragma unroll
        for (int d = 0; d < 4; ++d)
#pragma unroll
            for (int g = 0; g < 4; ++g) { const v2u gw = *(const GAS v2u*)(grow + 32 * d + 8 * g);
                const float g0 = bflo(gw.x), g1 = bfhi(gw.x), g2 = bflo(gw.y), g3 = bfhi(gw.y);
                const float y0 = (g0 / (1.f + __expf(-g0))) * (o[d][4 * g] * rstd), y1 = (g1 / (1.f + __expf(-g1))) * (o[d][4 * g + 1] * rstd);
                const float y2 = (g2 / (1.f + __expf(-g2))) * (o[d][4 * g + 2] * rstd), y3 = (g3 / (1.f + __expf(-g3))) * (o[d][4 * g + 3] * rstd);
                v2u w; w.x = cvtpk_s(y0, y1); w.y = cvtpk_s(y2, y3); *(GAS v2u*)(orow + 32 * d + 8 * g) = w; }
    }
}
template <int MODE> __device__ __forceinline__ void attn_phase(LAS unsigned char* lds, const int wave_s, int layer, int qk = 0) {
    constexpr int NH = (MODE == 0) ? 12 : 8, NU = BATCH * NH * 16;
    unsigned char* ws = KA_WS(); const int tid = tid_now(wave_s);
    unsigned* ctr = queue_word(ws, layer, MODE + qk);
    volatile LAS unsigned* uw = (volatile LAS unsigned*)(lds + LDSCTL_OFF);
    for (;;) {
        __syncthreads();
        if (tid == 0) uw[0] = __hip_atomic_fetch_add(ctr, 1u, __ATOMIC_RELAXED, __HIP_MEMORY_SCOPE_AGENT);
        __syncthreads();
        const unsigned u = uw[0];
        if (u >= (unsigned)NU) break;
        const int qb = 15 - (int)(u / (BATCH * NH)), bh = (int)(u % (BATCH * NH));
        attn_unit<MODE>(lds, ws, bh / NH, bh % NH, qb, tid);
    }
}

__device__ __forceinline__ float relu_i(float x) { const int i = __builtin_bit_cast(int, x); return __builtin_bit_cast(float, i > 0 ? i : 0); }
__device__ __forceinline__ void indexer_mfma(LAS unsigned char* lds, const int wave_s) {
    Frame F = make_frame(lds, wave_s);
    const bf16* proj = (const bf16*)(F.ws + WS_PROJ); int* sel = (int*)(F.ws + WS_SEL); float* isc = (float*)(F.ws + WS_ISC);
    const int lane = F.lane, r32 = lane & 31, hh = lane >> 5;
    for (int vw = blockIdx.x; vw < 256; vw += NWG)
    for (int it = 0; it < 2; ++it) {
        const int b = vw >> 7; const int jq = it ? (255 - (vw & 127)) : (vw & 127); const int t0 = 16 * jq, tA = t0 + 2 * F.wave; const size_t mA = (size_t)b * T + tA;
        if (t0 + 15 < TOPK) {
            for (int j = lane; j <= tA; j += 64) sel[mA * TOPK + j] = j;
            for (int j = lane; j <= tA + 1; j += 64) sel[(mA + 1) * TOPK + j] = j;
            continue; }
        bf16x8 afA[8], afB[8];
        { const GAS v4u* qp = (const GAS v4u*)(proj + mA * NIN + C_IQ + r32 * 128); const GAS v4u* qp2 = (const GAS v4u*)(proj + (mA + 1) * NIN + C_IQ + r32 * 128);
#pragma unroll
          for (int ks = 0; ks < 8; ++ks) { afA[ks] = __builtin_bit_cast(bf16x8, qp[2 * ks + hh]); afB[ks] = __builtin_bit_cast(bf16x8, qp2[2 * ks + hh]); } }
        float wvA[16], wvB[16];
#pragma unroll
        for (int r = 0; r < 16; ++r) { wvA[r] = bf2f(proj[mA * NIN + C_IW + crow(r, hh)]) * (0.17677669529663687f * 0.08838834764831845f);
                                       wvB[r] = bf2f(proj[(mA + 1) * NIN + C_IW + crow(r, hh)]) * (0.17677669529663687f * 0.08838834764831845f); }
        float* srowA = isc + mA * T; float* srowB = srowA + T;
        const int nch = (t0 + 15) / 256 + 1;
        const char* ikb = (const char*)(F.ws + WS_IKC) + (size_t)b * T * 256;
        const unsigned lane_off = (unsigned)((lane >> 4) * 256 + (((lane & 15) ^ ((4 * (F.wave & 3) + (lane >> 4)) & 15)) << 4));
        auto issue = [&](int c, int i0, int n) {
            LAS unsigned char* dst = F.lds + (c & 1) * 65536; int cc = c; asm volatile("" : "+s"(cc)); unsigned lo_ = lane_off; asm volatile("" : "+v"(lo_));
            for (int i = i0; i < i0 + n; ++i) { const int pi = F.wave + 8 * i; const unsigned off = lo_ + (unsigned)((cc * 256 + 4 * pi) * 256);
                __builtin_amdgcn_global_load_lds((const GAS unsigned*)(ikb + off), (LAS unsigned*)(dst + pi * 1024), 16, 0, 0); }
        };
        __syncthreads();
        issue(0, 0, 8);
        f32x16 a0, b0, a1, b1;
#pragma unroll
        for (int i = 0; i < 16; ++i) { a1[i] = 0.f; b1[i] = 0.f; }
        float xa0 = 0.f, xb0 = 0.f; int sprev = -1;
        for (int c = 0; c < nch; ++c) {
            if (c == 0) VM_WAIT(); else asm volatile("s_waitcnt vmcnt(4)" ::: "memory");
            __syncthreads();
            const bool more = c + 1 < nch;
            const LAS unsigned char* kb = F.lds + (c & 1) * 65536 + r32 * 256;
#pragma unroll 1
            for (int pp = 0; pp < 4; ++pp) {
                const int s0 = c * 256 + pp * 64; if (s0 > tA + 1) break;
                int ll = lane & 15; asm volatile("" : "+v"(ll));
                const LAS unsigned char* kbp = kb + (pp * 64) * 256;
                if (more && pp < 2) issue(c + 1, pp * 4, 2);
                __builtin_amdgcn_sched_barrier(0);
#pragma unroll
                for (int i = 0; i < 16; ++i) { a0[i] = 0.f; b0[i] = 0.f; }
                float xa1 = 0.f, xb1 = 0.f;
#pragma unroll
                for (int ks = 0; ks < 8; ++ks) { const bf16x8 bk = *(const LAS bf16x8*)(kbp + (((2 * ks + hh) ^ ll) << 4)); a0 = MFMA32(afA[ks], bk, a0); b0 = MFMA32(afB[ks], bk, b0); }
#pragma unroll
                for (int r = 0; r < 16; ++r) { xa1 = fmaf(wvA[r], relu_i(a1[r]), xa1); xb1 = fmaf(wvB[r], relu_i(b1[r]), xb1); }
#pragma unroll
                for (int i = 0; i < 16; ++i) { __builtin_amdgcn_sched_group_barrier(0x008, 1, 0); __builtin_amdgcn_sched_group_barrier(0x002, 4, 0); }
                __builtin_amdgcn_sched_barrier(0);
                asm volatile("" : "+v"(xa1), "+v"(xb1));
                if (sprev >= 0) {
                    const float ta0 = xa0 + __shfl_xor(xa0, 32), ta1 = xa1 + __shfl_xor(xa1, 32), tb0 = xb0 + __shfl_xor(xb0, 32), tb1 = xb1 + __shfl_xor(xb1, 32);
                    srowA[sprev + lane] = hh ? ta1 : ta0;
                    srowB[sprev + lane] = hh ? tb1 : tb0; }
                if (more && pp < 2) issue(c + 1, pp * 4 + 2, 2);
                __builtin_amdgcn_sched_barrier(0);
#pragma unroll
                for (int i = 0; i < 16; ++i) { a1[i] = 0.f; b1[i] = 0.f; }
                xa0 = 0.f; xb0 = 0.f;
#pragma unroll
                for (int ks = 0; ks < 8; ++ks) { const bf16x8 bk = *(const LAS bf16x8*)(kbp + 32 * 256 + (((2 * ks + hh) ^ ll) << 4)); a1 = MFMA32(afA[ks], bk, a1); b1 = MFMA32(afB[ks], bk, b1); }
#pragma unroll
                for (int r = 0; r < 16; ++r) { xa0 = fmaf(wvA[r], relu_i(a0[r]), xa0); xb0 = fmaf(wvB[r], relu_i(b0[r]), xb0); }
#pragma unroll
                for (int i = 0; i < 16; ++i) { __builtin_amdgcn_sched_group_barrier(0x008, 1, 0); __builtin_amdgcn_sched_group_barrier(0x002, 4, 0); }
                __builtin_amdgcn_sched_barrier(0);
                sprev = s0;
            }
        }
        { float xa1 = 0.f, xb1 = 0.f;
#pragma unroll
          for (int r = 0; r < 16; ++r) { xa1 = fmaf(wvA[r], relu_i(a1[r]), xa1); xb1 = fmaf(wvB[r], relu_i(b1[r]), xb1); }
          const float ta0 = xa0 + __shfl_xor(xa0, 32), ta1 = xa1 + __shfl_xor(xa1, 32), tb0 = xb0 + __shfl_xor(xb0, 32), tb1 = xb1 + __shfl_xor(xb1, 32);
          srowA[sprev + lane] = hh ? ta1 : ta0;
          srowB[sprev + lane] = hh ? tb1 : tb0; }
        VM_WAIT(); asm volatile("" ::: "memory");
        int lane2 = lane; asm volatile("" : "+v"(lane2));
#pragma unroll 1
        for (int qq = 0; qq < 2; ++qq) {
            const int t = tA + qq; const size_t m = mA + qq;
            unsigned u[64]; float s1 = 0.f, s2 = 0.f;
            { const float* sp = (qq ? srowB : srowA) + lane2;
#pragma unroll
              for (int g = 0; g < 64; ++g) { const float v = sp[g * 64]; const bool ok = (g * 64 + lane2 <= t); u[g] = ok ? sortable(v) : 0u;
                                             if ((g & 3) == 0) { const float vm = ok ? v : 0.f; s1 += vm; s2 = fmaf(vm, vm, s2); } } }
            s1 = wave_sum(s1); s2 = wave_sum(s2);
            float candf, dens;
            { const int nf = (t + 1 - 64) / 256 + 1, nfc = nf > 16 ? 16 : nf; int part = t + 1 - 256 * nfc; part = part < 0 ? 0 : (part > 64 ? 64 : part); const float ns = (float)(64 * nfc + (nfc < 16 ? part : 0));
              const float mu = s1 / ns, var = fmaxf(s2 / ns - mu * mu, 1e-30f), sd = sqrtf(var);
              const float n = (float)(t + 1), p = (float)TOPK / n, pm = fminf(p, 1.f - p);
              const float tt = sqrtf(-2.f * __logf(pm)); float z = tt - (2.30753f + 0.27061f * tt) / (1.f + tt * (0.99229f + 0.04481f * tt)); if (p > 0.5f) z = -z;
              dens = fmaxf(n * 0.3989423f * __expf(-0.5f * z * z) / sd, 1e-20f); candf = mu + z * sd; }
            unsigned lo_u = 1u, hi_u = 0xFFFFFFFFu, thr = 1u, cl = 0u; float lo_f = 0.f, hi_f = 0.f; int cnt_lo = 0, cnt_hi = 0; bool lo_ok = false, hi_ok = false, exact = false;
            for (int it = 0; ; ++it) {
                if (hi_u - lo_u <= 1u) { thr = lo_u; break; }
                unsigned cu = sortable(candf);
                if (it >= 12 || !(cu > lo_u && cu < hi_u)) cu = lo_u + ((hi_u - lo_u) >> 1);
                cl = 0u;
#pragma unroll
                for (int g = 0; g < 64; ++g) cl += (u[g] >= cu) ? 1u : 0u;
                int cnt = 0;
#pragma unroll
                for (int k = 0; k < 7; ++k) cnt += __popcll(__ballot((cl >> k) & 1u)) << k;
                if (cnt == TOPK) { thr = cu; exact = true; break; }
                const float cf = __builtin_bit_cast(float, (cu & 0x80000000u) ? (cu & 0x7fffffffu) : ~cu);
                if (cnt > TOPK) { lo_u = cu; lo_f = cf; cnt_lo = cnt; lo_ok = true; } else { hi_u = cu; hi_f = cf; cnt_hi = cnt; hi_ok = true; }
                if (lo_ok && hi_ok) candf = lo_f + (hi_f - lo_f) * (((float)cnt_lo - 255.5f) / (float)(cnt_lo - cnt_hi));
                else { candf = cf + ((float)cnt - 255.5f) / dens; dens *= 0.5f; }
            }
            if (exact) {
                int pre = 0; const unsigned long long ltm = (1ull << lane2) - 1ull;
#pragma unroll
                for (int k = 0; k < 7; ++k) pre += __popcll(__ballot((cl >> k) & 1u) & ltm) << k;
                int* sp2 = sel + m * TOPK + pre;
#pragma unroll
                for (int g = 0; g < 64; ++g) { if (u[g] >= thr) { *sp2 = g * 64 + lane2; ++sp2; } }
            } else {
            int cgt = 0;
            { unsigned cl2 = 0u;
#pragma unroll
              for (int g = 0; g < 64; ++g) cl2 += (u[g] > thr) ? 1u : 0u;
#pragma unroll
              for (int k = 0; k < 7; ++k) cgt += __popcll(__ballot((cl2 >> k) & 1u)) << k; }
            const int need_eq = TOPK - cgt; int base = 0, eq_seen = 0;
            const unsigned long long ltmask = (1ull << lane2) - 1ull;
#pragma unroll
            for (int g = 0; g < 64; ++g) {
                const bool gt = u[g] > thr, eq = u[g] == thr;
                const unsigned long long meq = __ballot(eq);
                const bool take = gt || (eq && (eq_seen + __popcll(meq & ltmask)) < need_eq);
                const unsigned long long ms = __ballot(take);
                if (take) sel[m * TOPK + base + __popcll(ms & ltmask)] = g * 64 + lane2;
                base += __popcll(ms); eq_seen += __popcll(meq);
            }
            }
            asm volatile("" ::: "memory");
        }
    }
}

#define MFMA16(a, b, c) __builtin_amdgcn_mfma_f32_16x16x32_bf16((a), (b), (c), 0, 0, 0)
#define SCHED_FENCE() __builtin_amdgcn_sched_barrier(0)
__device__ __forceinline__ void dsa_fast(LAS unsigned char* lds, const int wave_s, int layer, int qk = 0) {
    Frame F = make_frame(lds, wave_s);
    const bf16* proj = (const bf16*)(F.ws + WS_PROJ); const int* sel = (const int*)(F.ws + WS_SEL); bf16* mix = (bf16*)(F.ws + WS_MIX);
    LAS unsigned char* vring = F.lds + RING_OFF + F.wave * 16384;
    LAS unsigned char* xtra = F.lds + XTRA_OFF + F.wave * XTRA_WAVE;
    LAS unsigned short* il = (LAS unsigned short*)xtra;
    LAS float* sl = (LAS float*)(xtra + 512);
    volatile LAS unsigned* uw = (volatile LAS unsigned*)(F.lds + LDSCTL_OFF);
    const int lane = F.lane, c16 = lane & 15, kq = lane >> 4; const int tid = F.wave * 64 + lane;
    constexpr float C2 = 0.08838834764831845f * 1.4426950408889634f;
    const unsigned koff = (unsigned)(((lane & 15) ^ (lane >> 4)) << 4);
    const unsigned voff0 = (unsigned)(((lane & 15) ^ (2 * (lane >> 4))) << 4), voff1 = voff0 ^ 128u;
    const int trq = (lane & 15) >> 2, trp = lane & 3;
    int combo = (int)(xb_xcc_id() & 7u), tries = 0;
    bf16x8 ones;
#pragma unroll
    for (int j = 0; j < 8; ++j) ones[j] = (short)0x3F80;
    unsigned pend = 0u;
    if (tid == 0) pend = __hip_atomic_fetch_add(queue_word(F.ws, layer, 8 + combo + qk), 1u, __ATOMIC_RELAXED, __HIP_MEMORY_SCOPE_AGENT);
    for (int itn = 0;; ++itn) {
        if (tid == 0) {
            unsigned u = 0xffffffffu, v = pend;
            for (;;) { if (v < 512u) { u = (unsigned)combo * 512u + v; break; } combo = (combo + 1) & 7; if (++tries >= 8) break;
                v = __hip_atomic_fetch_add(queue_word(F.ws, layer, 8 + combo + qk), 1u, __ATOMIC_RELAXED, __HIP_MEMORY_SCOPE_AGENT); }
            uw[itn & 1] = u;
            if (u != 0xffffffffu) pend = __hip_atomic_fetch_add(queue_word(F.ws, layer, 8 + combo + qk), 1u, __ATOMIC_RELAXED, __HIP_MEMORY_SCOPE_AGENT);
        }
        __syncthreads();
        const unsigned u = uw[itn & 1];
        if (u == 0xffffffffu) break;
        const int cb = (int)(u >> 9), b = cb >> 2, n = cb & 3, t = (int)(u & 511u) * 8 + F.wave; const size_t m = (size_t)b * T + t; const int nsel = (t + 1 < TOPK) ? t + 1 : TOPK;
        { int sv[4];
#pragma unroll
          for (int i = 0; i < 4; ++i) sv[i] = sel[m * TOPK + lane + 64 * i];
#pragma unroll
          for (int i = 0; i < 4; ++i) { const int j = lane + 64 * i; il[j] = (unsigned short)((j < nsel && (unsigned)sv[i] < (unsigned)T) ? sv[i] : 0); } }
        bf16x8 qf[4];
        { const GAS v4u* qp = (const GAS v4u*)(proj + m * NIN + C_DQ + (n * 3 + (c16 < 3 ? c16 : 0)) * 128);
          v4u w[4];
#pragma unroll
          for (int ks = 0; ks < 4; ++ks) w[ks] = qp[ks * 4 + kq];
#pragma unroll
          for (int ks = 0; ks < 4; ++ks) { if (c16 >= 3) w[ks] = (v4u){0u, 0u, 0u, 0u}; qf[ks] = __builtin_bit_cast(bf16x8, w[ks]); } }
        LDS_WAIT(); asm volatile("" ::: "memory");
        const char* kslab = (const char*)((const bf16*)(F.ws + WS_DKC) + ((size_t)(b * 4 + n)) * T * 128);
        const char* vslab = (const char*)((const bf16*)(F.ws + WS_DVC) + ((size_t)(b * 4 + n)) * T * 128);
        f32x4 sc[16];
#define DSA_KDMA(kr) do { LAS unsigned char* dst = vring + ((kr) & 1) * 8192; _Pragma("unroll") for (int i = 0; i < 8; ++i) { \
            const unsigned idx = il[32 * (kr) + 4 * i + (lane >> 4)]; const unsigned off = idx * 256u + (koff ^ (unsigned)((i & 3) << 6)); \
            __builtin_amdgcn_global_load_lds((const GAS unsigned*)(kslab + off), (LAS unsigned*)(dst + i * 1024), 16, 0, 0); } } while (0)
#define DSA_VDMA(kb) do { LAS unsigned char* dst = vring + ((kb) & 1) * 8192; _Pragma("unroll") for (int i = 0; i < 8; ++i) { \
            const unsigned idx = il[32 * (kb) + 4 * i + (lane >> 4)]; const unsigned off = idx * 256u + (((i >> 1) & 1) ? voff1 : voff0); \
            __builtin_amdgcn_global_load_lds((const GAS unsigned*)(vslab + off), (LAS unsigned*)(dst + i * 1024), 16, 0, 0); } } while (0)
#define DSA_KDMA1(kr, i) do { const unsigned idx = il[32 * (kr) + 4 * (i) + (lane >> 4)]; const unsigned off = idx * 256u + (koff ^ (unsigned)(((i) & 3) << 6)); \
            __builtin_amdgcn_global_load_lds((const GAS unsigned*)(kslab + off), (LAS unsigned*)(vring + ((kr) & 1) * 8192 + (i) * 1024), 16, 0, 0); } while (0)
#define DSA_VDMA1(kb, i) do { const unsigned idx = il[32 * (kb) + 4 * (i) + (lane >> 4)]; const unsigned off = idx * 256u + ((((i) >> 1) & 1) ? voff1 : voff0); \
            __builtin_amdgcn_global_load_lds((const GAS unsigned*)(vslab + off), (LAS unsigned*)(vring + ((kb) & 1) * 8192 + (i) * 1024), 16, 0, 0); } while (0)
        DSA_KDMA(0); DSA_KDMA(1);
#pragma unroll
        for (int kr = 0; kr < 8; ++kr) {
            asm volatile("s_waitcnt vmcnt(8)" ::: "memory");
            const LAS unsigned char* ks_ = vring + (kr & 1) * 8192 + c16 * 256;
            bf16x8 af_[2][4];
#pragma unroll
            for (int bi = 0; bi < 2; ++bi)
#pragma unroll
                for (int ks = 0; ks < 4; ++ks) af_[bi][ks] = *(const LAS bf16x8*)(ks_ + bi * 4096 + (((ks * 4 + kq) ^ c16) << 4));
            LDS_WAIT(); asm volatile("" ::: "memory");
            f32x4 acc0 = (f32x4){0.f, 0.f, 0.f, 0.f}, acc1 = (f32x4){0.f, 0.f, 0.f, 0.f};
#pragma unroll
            for (int p = 0; p < 8; ++p) {
                if (p < 4) acc0 = MFMA16(af_[0][p & 3], qf[p & 3], acc0); else acc1 = MFMA16(af_[1][p & 3], qf[p & 3], acc1);
                SCHED_FENCE();
                if (kr + 2 < 8) { DSA_KDMA1(kr + 2, p); } else { DSA_VDMA1(kr - 6, p); }
                SCHED_FENCE();
            }
            sc[2 * kr] = acc0; sc[2 * kr + 1] = acc1;
        }
        if (nsel < TOPK) {
#pragma unroll
            for (int blk = 0; blk < 16; ++blk)
#pragma unroll
                for (int i = 0; i < 4; ++i) { const int j = blk * 16 + 4 * kq + i; if (j >= nsel) sc[blk][i] = -__builtin_inff(); }
        }
        float mx = sc[0][0];
#pragma unroll
        for (int blk = 0; blk < 16; ++blk)
#pragma unroll
            for (int i = 0; i < 4; ++i) mx = fmaxf(mx, sc[blk][i]);
        mx = fmaxf(mx, __shfl_xor(mx, 16)); mx = fmaxf(mx, __shfl_xor(mx, 32));
        if (c16 < 3) {
#pragma unroll
            for (int blk = 0; blk < 16; ++blk) *(LAS f32x4*)(sl + c16 * 256 + blk * 16 + 4 * kq) = sc[blk];
        }
        const float m0 = -rdlane(mx, 0) * C2, m1 = -rdlane(mx, 1) * C2, m2 = -rdlane(mx, 2) * C2;
        LDS_WAIT(); asm volatile("" ::: "memory");
        { const f32x4 s0 = *(const LAS f32x4*)(sl + 4 * lane), s1 = *(const LAS f32x4*)(sl + 256 + 4 * lane), s2 = *(const LAS f32x4*)(sl + 512 + 4 * lane);
          float p0[4], p1[4], p2[4];
#pragma unroll
          for (int e = 0; e < 4; ++e) { p0[e] = __builtin_amdgcn_exp2f(fmaf(s0[e], C2, m0)); p1[e] = __builtin_amdgcn_exp2f(fmaf(s1[e], C2, m1)); p2[e] = __builtin_amdgcn_exp2f(fmaf(s2[e], C2, m2)); }
          LDS_WAIT(); asm volatile("" ::: "memory");
          LAS unsigned char* pb = (LAS unsigned char*)sl;
          *(LAS v2u*)(pb + 8 * lane) = (v2u){cvtpk_s(p0[0], p0[1]), cvtpk_s(p0[2], p0[3])};
          *(LAS v2u*)(pb + 512 + 8 * lane) = (v2u){cvtpk_s(p1[0], p1[1]), cvtpk_s(p1[2], p1[3])};
          *(LAS v2u*)(pb + 1024 + 8 * lane) = (v2u){cvtpk_s(p2[0], p2[1]), cvtpk_s(p2[2], p2[3])}; }
        LDS_WAIT(); asm volatile("" ::: "memory");
        f32x4 oacc[8], lacc = (f32x4){0.f, 0.f, 0.f, 0.f};
#pragma unroll
        for (int d = 0; d < 8; ++d) oacc[d] = (f32x4){0.f, 0.f, 0.f, 0.f};
        const LAS unsigned char* pbr = (const LAS unsigned char*)sl + (c16 < 3 ? c16 : 0) * 512 + kq * 16;
        const int trrow = (8 * kq + trq) * 256; const int trsw = 2 * trq + 8 * (kq & 1);
#pragma unroll 1
        for (int kb = 0; kb < 8; ++kb) {
            if (kb < 7) asm volatile("s_waitcnt vmcnt(8)" ::: "memory"); else asm volatile("s_waitcnt vmcnt(0)" ::: "memory");
            const LAS unsigned char* vs = vring + (kb & 1) * 8192 + trrow + (trp & 1) * 8;
            v4u pw = *(const LAS v4u*)(pbr + kb * 64); if (c16 >= 3) pw = (v4u){0u, 0u, 0u, 0u};
            const bf16x8 pf = __builtin_bit_cast(bf16x8, pw);
            bf16x8 vf_[8];
#pragma unroll
            for (int d = 0; d < 8; ++d) { const int cpos = ((2 * d + (trp >> 1)) ^ trsw) << 4;
                const s16x4 lo = vtr((const LAS char*)(vs + cpos)), hi = vtr((const LAS char*)(vs + 4 * 256 + cpos));
                vf_[d] = __builtin_shufflevector(lo, hi, 0, 1, 2, 3, 4, 5, 6, 7); }
            LDS_WAIT(); asm volatile("" ::: "memory");
            const bool rf = kb + 2 < 8; const int kn = rf ? kb + 2 : 7;
#pragma unroll
            for (int d = 0; d < 8; ++d) {
                oacc[d] = MFMA16(vf_[d], pf, oacc[d]);
                SCHED_FENCE();
                if (rf) { DSA_VDMA1(kn, d); }
                SCHED_FENCE();
            }
            lacc = MFMA16(ones, pf, lacc);
        }
#undef DSA_KDMA1
#undef DSA_VDMA1
#undef DSA_KDMA
#undef DSA_VDMA
        if (c16 < 3) { const float il_ = 1.f / lacc[0]; bf16* orow = mix + m * MIXW + MIX_DSA + (n * 3 + c16) * 128 + 4 * kq;
#pragma unroll
            for (int d = 0; d < 8; ++d) *(GAS v2u*)(orow + 16 * d) = (v2u){cvtpk_s(oacc[d][0] * il_, oacc[d][1] * il_), cvtpk_s(oacc[d][2] * il_, oacc[d][3] * il_)}; }
        asm volatile("s_waitcnt vmcnt(0) lgkmcnt(0)" ::: "memory");
    }
}

struct Args { const float* in[12]; float* out; unsigned char* ws; };
__device__ __forceinline__ void grid_bar(LAS unsigned char* lds, const int wave_s) {
    XcdBarrier b; b.bar = (unsigned*)(KA_WS() + WS_CTL) + CW_BAR; b.x = xb_xcc_id(); b.st = (volatile LAS unsigned*)(lds + MISC_OFF) + 8;
    xcd_barrier(b, tid_now(wave_s));
}
__global__ void __launch_bounds__(NWAVES * 64, 2) fwd_kernel(Args args) {
    extern __shared__ __attribute__((aligned(16))) unsigned char lds_raw[];
    LAS unsigned char* lds = (LAS unsigned char*)lds_raw;
    const int wave_s = __builtin_amdgcn_readfirstlane((int)threadIdx.x >> 6);
    for (int u = threadIdx.x; u < (LDS_BYTES - LDSCTL_OFF) / 4; u += NWAVES * 64) ((LAS unsigned*)(lds + LDSCTL_OFF))[u] = 0u;
    __syncthreads();
    (void)xcd_barrier_post((unsigned*)(KA_WS() + WS_CTL) + CW_BAR, (volatile LAS unsigned*)(lds + MISC_OFF) + 8);
#define GRID_BAR() grid_bar(lds, wave_s)
#define WSP(T_, off) ((T_*)(ws + (off)))

    p0_prologue(lds, wave_s);
    GRID_BAR();

#pragma unroll 1
    for (int l = 0; l < DEPTH; ++l) {
        const int Gg = inproj_gemm_wgs(NWG);
        if ((int)blockIdx.x >= Gg) side_convert(lds, wave_s, l, (int)blockIdx.x - Gg, NWG - Gg);
        else
        { unsigned char* ws = KA_WS(); unsigned char* wl = ws + WS_W + (size_t)l * SZ_WLAYER;
          pg8::Gemm g{WSP(bf16, WS_U), (const bf16*)(wl + OFF_WIN), M, NIN, DM}; pg8::StaticOrder S; S.init(M, NIN, Gg, (int)blockIdx.x);
          pg8::EpiBf16<0> E{WSP(bf16, WS_PROJ), NIN, 0, (const float*)(ws + WS_CTL) + CW_ROWSS + (size_t)(2 * l) * M, 1.0f / DM};
          pg8::gemm_phase<pg8::EpiBf16<0>, pg8::StaticOrder, true, true>(lds + RING_OFF, g, S, E, tid_now(wave_s)); }
        if (Gg == NWG) side_convert(lds, wave_s, l, (int)blockIdx.x, NWG);
        GRID_BAR();
        prep_phase(lds, wave_s, l);
        GRID_BAR();
        { unsigned char* ws = KA_WS(); unsigned char* wl = ws + WS_W + (size_t)l * SZ_WLAYER;
          pg8::Gemm g{WSP(bf16, WS_CQN), (const bf16*)(wl + OFF_WUQ), M, NUQ, QL}; pg8::StaticOrder S; S.init(M, NUQ, NWG, (int)((blockIdx.x + NWG / 2) % NWG));
          pg8::EpiBf16<0> E{WSP(bf16, WS_QMLA), NUQ, 0, nullptr, 0.f};
          pg8::gemm_phase<pg8::EpiBf16<0>, pg8::StaticOrder, true, true>(lds + RING_OFF, g, S, E, tid_now(wave_s)); }
        { unsigned char* ws = KA_WS(); unsigned char* wl = ws + WS_W + (size_t)l * SZ_WLAYER;
          pg8::Gemm g{WSP(bf16, WS_CKVN), (const bf16*)(wl + OFF_WUKV), M, NUKV, KVL}; pg8::StaticOrder S; S.init(M, NUKV, NWG, (int)blockIdx.x);
          pg8::EpiBf16<0> E{WSP(bf16, WS_KVMLA), 256, (size_t)M * 256, nullptr, 0.f};
          pg8::gemm_phase<pg8::EpiBf16<0>, pg8::StaticOrder, true, true>(lds + RING_OFF, g, S, E, tid_now(wave_s)); }
        __syncthreads();
        indexer_mfma(lds, wave_s);
        attn_phase<2>(lds, wave_s, l);
        GRID_BAR();
        if ((int)blockIdx.x >= NWG - ATT_CONV) wdn_convert(lds, wave_s, l, (int)blockIdx.x - (NWG - ATT_CONV));
        attn_phase<0>(lds, wave_s, l);
        attn_phase<1>(lds, wave_s, l);
        dsa_fast(lds, wave_s, l);
        GRID_BAR();
        { unsigned char* ws = KA_WS(); unsigned char* wl = ws + WS_W + (size_t)l * SZ_WLAYER;
          pg8::Gemm g{WSP(bf16, WS_MIX), (const bf16*)(wl + OFF_WO), M, DM, MIXW}; pg8::StaticOrder S; S.init(M, DM, NWG, (int)blockIdx.x);
          pg8::EpiRes E{l == 0 ? KA_IN(0) : (const float*)nullptr, (float*)nullptr, DM, WSP(bf16, WS_U), (float*)(ws + WS_CTL) + CW_ROWSS + (size_t)(2 * l + 1) * M};
          pg8::gemm_phase<pg8::EpiRes, pg8::StaticOrder, true, true>(lds + RING_OFF, g, S, E, tid_now(wave_s)); }
        GRID_BAR();
        { unsigned char* ws = KA_WS(); unsigned char* wl = ws + WS_W + (size_t)l * SZ_WLAYER;
          pg8::Gemm g{WSP(bf16, WS_U), (const bf16*)(wl + OFF_WUP), M, FF, DM}; pg8::StaticOrder S; S.init(M, FF, NWG, (int)blockIdx.x);
          pg8::EpiBf16<1> E{WSP(bf16, WS_HID), FF, 0, (const float*)(ws + WS_CTL) + CW_ROWSS + (size_t)(2 * l + 1) * M, 1.0f / DM};
          pg8::gemm_phase<pg8::EpiBf16<1>, pg8::StaticOrder, true, true>(lds + RING_OFF, g, S, E, tid_now(wave_s)); }
        GRID_BAR();
        if (l + 1 < DEPTH)
        { unsigned char* ws = KA_WS(); unsigned char* wl = ws + WS_W + (size_t)l * SZ_WLAYER;
          pg8::Gemm g{WSP(bf16, WS_HID), (const bf16*)(wl + OFF_WDN), M, DM, FF}; pg8::StaticOrder S; S.init(M, DM, NWG, (int)blockIdx.x);
          pg8::EpiRes E{(const float*)nullptr, (float*)nullptr, DM, WSP(bf16, WS_U), (float*)(ws + WS_CTL) + CW_ROWSS + (size_t)(2 * l + 2) * M};
          pg8::gemm_phase<pg8::EpiRes, pg8::StaticOrder, true, true>(lds + RING_OFF, g, S, E, tid_now(wave_s));
          GRID_BAR(); }
        else
        { unsigned char* ws = KA_WS(); unsigned char* wl = ws + WS_W + (size_t)l * SZ_WLAYER;
          pg8::Gemm g{WSP(bf16, WS_HID), (const bf16*)(wl + OFF_WDN), M, DM, FF}; pg8::FinalOrder S; S.init(M, DM, NWG, (int)blockIdx.x);
          pg8::EpiFinal E{WSP(bf16, WS_U), KA_OUT(), DM, (float*)(ws + WS_CTL) + CW_ROWSS + (size_t)(2 * l + 2) * M, KA_IN(11), queue_word(ws, 2, 0)};
          pg8::gemm_phase<pg8::EpiFinal, pg8::FinalOrder, true, true>(lds + RING_OFF, g, S, E, tid_now(wave_s)); }
    }
}

extern "C" void kernel_launch(void* const* d_in, const int* in_sizes, int n_in, void* d_out, int out_size, void* d_ws, size_t ws_size, hipStream_t stream) {
    static int grid = 0;
    if (grid == 0) {
        if (n_in != 12 || in_sizes[0] != M * DM || out_size != M * DM || ws_size < WS_END) {
            fprintf(stderr, "kernel_launch: unexpected shapes (n_in %d in0 %d out %d ws %zu need %zu); nothing launched\n", n_in, n_in > 0 ? in_sizes[0] : -1, out_size, ws_size, (size_t)WS_END); grid = -1; return; }
        int dev = 0, cus = 0, per_cu = 0;
        if (hipGetDevice(&dev) != hipSuccess || hipDeviceGetAttribute(&cus, hipDeviceAttributeMultiprocessorCount, dev) != hipSuccess) { grid = -1; return; }
        if (hipFuncSetAttribute((const void*)fwd_kernel, hipFuncAttributeMaxDynamicSharedMemorySize, LDS_BYTES) != hipSuccess) { fprintf(stderr, "kernel_launch: hipFuncSetAttribute failed\n"); grid = -1; return; }
        if (hipOccupancyMaxActiveBlocksPerMultiprocessor(&per_cu, (const void*)fwd_kernel, NWAVES * 64, LDS_BYTES) != hipSuccess || per_cu < 1)
            fprintf(stderr, "kernel_launch: note: occupancy query reports %d workgroups per CU\n", per_cu);
        (void)hipGetLastError();
        if (cus != NWG) { fprintf(stderr, "kernel_launch: %d CUs, this kernel is built for %d; nothing launched\n", cus, NWG); grid = -1; return; }
        grid = NWG;
    }
    if (grid < 0) return;
    if (hipMemsetAsync((char*)d_ws + WS_CTL, 0, CTL_ZERO_BYTES, stream) != hipSuccess) return;
    Args a{};
    for (int i = 0; i < 12; ++i) a.in[i] = (const float*)d_in[i];
    a.out = (float*)d_out; a.ws = (unsigned char*)d_ws;
    hipLaunchKernelGGL(fwd_kernel, dim3(grid), dim3(NWAVES * 64), LDS_BYTES, stream, a);
    const hipError_t le = hipPeekAtLastError();
    if (le != hipSuccess) fprintf(stderr, "kernel_launch: launch failed: %s\n", hipGetErrorName(le));
}
```

```cpp
#include <hip/hip_runtime.h>
#include <cstdio>
#include <cstdint>
namespace pg8 {
#define PG8_LAS __attribute__((address_space(3)))
typedef unsigned short bf16_t;
typedef short bf16x8 __attribute__((ext_vector_type(8)));
typedef float f32x4 __attribute__((ext_vector_type(4)));
typedef unsigned u32x4 __attribute__((ext_vector_type(4)));
constexpr int BM = 256, BK = 64, HALF = 128, HTB = HALF * BK * 2  , STAGE_BYTES = 8 * HTB, NXCD = 8, WGM = 8;

__host__ __device__ __forceinline__ int lds_byte(int r, int c) { const int st = (r >> 4) * 2 + (c >> 5), rr = r & 15, cc = c & 31, ob = rr * 64 + cc * 2; return st * 1024 + (ob ^ (((ob >> 9) & 1) << 5)); }
__host__ __device__ __forceinline__ void stage_rc(int b, int& R, int& C) { const int st = b / 1024, sb = b % 1024, swz = sb ^ (((sb >> 9) & 1) << 5); R = (st >> 1) * 16 + swz / 64; C = (st & 1) * 32 + (swz % 64) / 2; }
__host__ __device__ __forceinline__ int perm32(int rho) { const int n = rho >> 4, i = rho & 15; return 8 * (i >> 2) + 4 * n + (i & 3); }

struct Unit { int pm, pn; };
struct Gemm { const bf16_t* A; const bf16_t* Bt; int M, N, K; };

struct StaticOrder {
    int nM, nN, nwg, G, c;
    __host__ __device__ void init(int M, int N, int G_, int c_) { nM = M / BM; nN = N / BM; nwg = nM * nN; G = G_; c = c_; }
    __host__ __device__ bool next(int i, Unit& u) const {
        const long L = (long)i * G + c; if (L >= nwg) return false;
        int wgid = (int)L; { const int q = nwg / NXCD, r = nwg % NXCD, xcd = wgid % NXCD, off = wgid / NXCD; wgid = (xcd < r ? xcd * (q + 1) : r * (q + 1) + (xcd - r) * q) + off; }
        const int nig = WGM * nN, gid = wgid / nig, fm = gid * WGM, gsz = (nM - fm) < WGM ? (nM - fm) : WGM;
        u.pm = fm + ((wgid % nig) % gsz); u.pn = (wgid % nig) / gsz; return true;
    }
    __device__ __forceinline__ void a_ready(const Unit&) const {}
    __device__ __forceinline__ void done(const Unit&) const {}
};

__device__ __forceinline__ unsigned cvt_pk_bf16(float lo, float hi) { unsigned r; asm volatile("v_cvt_pk_bf16_f32 %0, %1, %2" : "=v"(r) : "v"(lo), "v"(hi)); return r; }
typedef float f32x2 __attribute__((ext_vector_type(2)));
template <int ACT  > struct EpiBf16 {
    static constexpr bool PERM = true, AFTER_DRAIN = false;
    bf16_t* O; int ldc; size_t tile_stride;
    const float* rowss; float inv_k;
    __device__ __forceinline__ void operator()(const f32x4 (&acc)[2][2][4][2], const Unit& u, int wr, int wc, int fr, int fq) const {
        const int rb0 = u.pm * BM + wr * 64; const int colx = (tile_stride ? 0 : u.pn * BM) + wc * 64 + 8 * fq + (fr >> 3) * 32; const bool lo = fr < 8;
        bf16_t* Ob = O + (size_t)u.pn * tile_stride;
#pragma unroll
        for (int ai = 0; ai < 2; ++ai)
#pragma unroll
            for (int m = 0; m < 4; ++m) { const int rbase = rb0 + ai * HALF + m * 16;
                const float rs = rowss ? 1.0f / sqrtf(rowss[rbase + fr] * inv_k + 1e-6f) : 1.0f;
                u32x4 w[2];
#pragma unroll
                for (int bj = 0; bj < 2; ++bj) { f32x4 v0 = acc[ai][bj][m][0] * rs, v1 = acc[ai][bj][m][1] * rs;
                    if (ACT == 1) {
#pragma unroll
                        for (int j = 0; j < 4; ++j) { const float a = fmaxf(v0[j], 0.f), b = fmaxf(v1[j], 0.f); v0[j] = a * a; v1[j] = b * b; } }
                    w[bj].x = cvt_pk_bf16(v0[0], v0[1]); w[bj].y = cvt_pk_bf16(v0[2], v0[3]); w[bj].z = cvt_pk_bf16(v1[0], v1[1]); w[bj].w = cvt_pk_bf16(v1[2], v1[3]); }
                u32x4 t, r_, d1, d2;
                t.x = lo ? w[1].x : w[0].x; t.y = lo ? w[1].y : w[0].y; t.z = lo ? w[1].z : w[0].z; t.w = lo ? w[1].w : w[0].w;
                r_.x = (unsigned)__builtin_amdgcn_update_dpp(0, (int)t.x, 0x128, 0xf, 0xf, false); r_.y = (unsigned)__builtin_amdgcn_update_dpp(0, (int)t.y, 0x128, 0xf, 0xf, false);
                r_.z = (unsigned)__builtin_amdgcn_update_dpp(0, (int)t.z, 0x128, 0xf, 0xf, false); r_.w = (unsigned)__builtin_amdgcn_update_dpp(0, (int)t.w, 0x128, 0xf, 0xf, false);
                d1.x = lo ? w[0].x : r_.x; d1.y = lo ? w[0].y : r_.y; d1.z = lo ? w[0].z : r_.z; d1.w = lo ? w[0].w : r_.w;
                d2.x = lo ? r_.x : w[1].x; d2.y = lo ? r_.y : w[1].y; d2.z = lo ? r_.z : w[1].z; d2.w = lo ? r_.w : w[1].w;
                bf16_t* p1 = Ob + (size_t)(rbase + (fr & 7)) * ldc + colx; bf16_t* p2 = p1 + (size_t)8 * ldc;
                if (ACT == 1) { __builtin_nontemporal_store(d1, (u32x4*)p1); __builtin_nontemporal_store(d2, (u32x4*)p2); } else { *(u32x4*)p1 = d1; *(u32x4*)p2 = d2; } }
    }
};
struct EpiRes {
    static constexpr bool PERM = true, AFTER_DRAIN = false;
    const float* base32; float* out32; int ldc; bf16_t* hb; float* rowss;
    __device__ __forceinline__ void operator()(const f32x4 (&acc)[2][2][4][2], const Unit& u, int wr, int wc, int fr, int fq) const {
        const int row0 = u.pm * BM + wr * 64 + fr, col0 = u.pn * BM + wc * 64 + 8 * fq;
#pragma unroll
        for (int ai = 0; ai < 2; ++ai)
#pragma unroll
            for (int m = 0; m < 4; ++m) { const int r = row0 + ai * HALF + m * 16; const size_t off = (size_t)r * ldc + col0; float ss = 0.f;
#pragma unroll
                for (int bj = 0; bj < 2; ++bj) { const size_t o1 = off + bj * 32; f32x4 b0, b1;
                    if (base32) { b0 = *(const f32x4*)(base32 + o1); b1 = *(const f32x4*)(base32 + o1 + 4); }
                    else { const u32x4 w = *(const u32x4*)(hb + o1);
                        b0 = (f32x4){__builtin_bit_cast(float, w.x << 16), __builtin_bit_cast(float, w.x & 0xffff0000u), __builtin_bit_cast(float, w.y << 16), __builtin_bit_cast(float, w.y & 0xffff0000u)};
                        b1 = (f32x4){__builtin_bit_cast(float, w.z << 16), __builtin_bit_cast(float, w.z & 0xffff0000u), __builtin_bit_cast(float, w.w << 16), __builtin_bit_cast(float, w.w & 0xffff0000u)}; }
                    const f32x4 o0 = b0 + acc[ai][bj][m][0], o1v = b1 + acc[ai][bj][m][1];
                    if (out32) { __builtin_nontemporal_store(o0, (f32x4*)(out32 + o1)); __builtin_nontemporal_store(o1v, (f32x4*)(out32 + o1 + 4)); }
                    else { ss += ((o0[0] * o0[0] + o0[1] * o0[1]) + (o0[2] * o0[2] + o0[3] * o0[3])) + ((o1v[0] * o1v[0] + o1v[1] * o1v[1]) + (o1v[2] * o1v[2] + o1v[3] * o1v[3]));
                        u32x4 w; w.x = cvt_pk_bf16(o0[0], o0[1]); w.y = cvt_pk_bf16(o0[2], o0[3]); w.z = cvt_pk_bf16(o1v[0], o1v[1]); w.w = cvt_pk_bf16(o1v[2], o1v[3]); *(u32x4*)(hb + o1) = w; } }
                if (!out32) { ss += __shfl_xor(ss, 16); ss += __shfl_xor(ss, 32);
                    if (fq == 0) __hip_atomic_fetch_add(rowss + r, ss, __ATOMIC_RELAXED, __HIP_MEMORY_SCOPE_AGENT); } }
    }
};
struct EpiFinal {
    static constexpr bool PERM = true, AFTER_DRAIN = false;
    const bf16_t* hb; float* out; int ldc; float* rowss; const float* gfin; unsigned* cnt;
    __device__ __forceinline__ void operator()(const f32x4 (&acc)[2][2][4][2], const Unit& u, int wr, int wc, int fr, int fq) const {
        const int row0 = u.pm * BM + wr * 64 + fr, col0 = u.pn * BM + wc * 64 + 8 * fq;
#pragma unroll
        for (int ai = 0; ai < 2; ++ai)
#pragma unroll
            for (int m = 0; m < 4; ++m) { const int r = row0 + ai * HALF + m * 16; const size_t off = (size_t)r * ldc + col0; float ss = 0.f;
#pragma unroll
                for (int bj = 0; bj < 2; ++bj) { const u32x4 w = *(const u32x4*)(hb + off + bj * 32);
                    const f32x4 b0 = (f32x4){__builtin_bit_cast(float, w.x << 16), __builtin_bit_cast(float, w.x & 0xffff0000u), __builtin_bit_cast(float, w.y << 16), __builtin_bit_cast(float, w.y & 0xffff0000u)};
                    const f32x4 b1 = (f32x4){__builtin_bit_cast(float, w.z << 16), __builtin_bit_cast(float, w.z & 0xffff0000u), __builtin_bit_cast(float, w.w << 16), __builtin_bit_cast(float, w.w & 0xffff0000u)};
                    const f32x4 o0 = b0 + acc[ai][bj][m][0], o1v = b1 + acc[ai][bj][m][1];
                    ss += ((o0[0] * o0[0] + o0[1] * o0[1]) + (o0[2] * o0[2] + o0[3] * o0[3])) + ((o1v[0] * o1v[0] + o1v[1] * o1v[1]) + (o1v[2] * o1v[2] + o1v[3] * o1v[3])); }
                ss += __shfl_xor(ss, 16); ss += __shfl_xor(ss, 32);
                if (fq == 0) __hip_atomic_fetch_add(rowss + r, ss, __ATOMIC_RELAXED, __HIP_MEMORY_SCOPE_AGENT); }
        asm volatile("s_waitcnt vmcnt(0)" ::: "memory");
        unsigned* c = cnt + u.pm * 64;
        if (fr == 0 && fq == 0) { __hip_atomic_fetch_add(c, 1u, __ATOMIC_RELAXED, __HIP_MEMORY_SCOPE_AGENT);
            int spins = 0; while (__hip_atomic_load(c, __ATOMIC_RELAXED, __HIP_MEMORY_SCOPE_AGENT) < 128u && ++spins < (1 << 22)) __builtin_amdgcn_s_sleep(2); }
        asm volatile("" ::: "memory");
#pragma unroll
        for (int ai = 0; ai < 2; ++ai)
#pragma unroll
            for (int m = 0; m < 4; ++m) { const int r = row0 + ai * HALF + m * 16; const size_t off = (size_t)r * ldc + col0;
                const float rs = 1.0f / sqrtf(__hip_atomic_load(rowss + r, __ATOMIC_RELAXED, __HIP_MEMORY_SCOPE_AGENT) * (1.0f / 4096.0f) + 1e-6f);
#pragma unroll
                for (int bj = 0; bj < 2; ++bj) { const size_t o1 = off + bj * 32; const u32x4 w = *(const u32x4*)(hb + o1);
                    const f32x4 b0 = (f32x4){__builtin_bit_cast(float, w.x << 16), __builtin_bit_cast(float, w.x & 0xffff0000u), __builtin_bit_cast(float, w.y << 16), __builtin_bit_cast(float, w.y & 0xffff0000u)};
                    const f32x4 b1 = (f32x4){__builtin_bit_cast(float, w.z << 16), __builtin_bit_cast(float, w.z & 0xffff0000u), __builtin_bit_cast(float, w.w << 16), __builtin_bit_cast(float, w.w & 0xffff0000u)};
                    const f32x4 g0 = *(const f32x4*)(gfin + col0 + bj * 32), g1 = *(const f32x4*)(gfin + col0 + bj * 32 + 4);
                    __builtin_nontemporal_store(((b0 + acc[ai][bj][m][0]) * rs) * g0, (f32x4*)(out + o1)); __builtin_nontemporal_store(((b1 + acc[ai][bj][m][1]) * rs) * g1, (f32x4*)(out + o1 + 4)); } }
    }
};
struct FinalOrder {
    int c;
    __host__ __device__ void init(int, int, int, int c_) { c = c_; }
    __host__ __device__ bool next(int i, Unit& u) const { if (i >= 2) return false; const int x = c & 7, j = c >> 3; u.pm = 16 * i + 8 * (x & 1) + (j & 7); u.pn = 4 * (x >> 1) + (j >> 3); return true; }
    __device__ __forceinline__ void a_ready(const Unit&) const {}
    __device__ __forceinline__ void done(const Unit&) const {}
};
template <class Epi, class Sched, bool ALIGN_EPI = false, bool SP2 = false>
__device__ __forceinline__ void gemm_phase(PG8_LAS unsigned char* lds, const Gemm g, const Sched& S, const Epi& E, const int tid_arg) {
    int tid_ = tid_arg; asm volatile("" : "+v"(tid_));
    const int tid = tid_, wid = __builtin_amdgcn_readfirstlane(tid >> 6), lane = tid & 63, wr = wid >> 2, wc = wid & 3, fr = lane & 15, fq = lane >> 4;
    const int K = g.K, nt = K / BK;
    unsigned voffA[2], voffB[2];
#pragma unroll
    for (int i = 0; i < 2; ++i) { int R, C; stage_rc(tid * 16 + i * 8192, R, C); const int Rb = Epi::PERM ? ((R >> 5) * 64 + perm32(R & 31)) : R;
        voffA[i] = (unsigned)(R * K + C) * 2u; voffB[i] = (unsigned)(Rb * K + C) * 2u; }
    const size_t kstep = (size_t)(BK * 2);
    const size_t hstep = (size_t)HALF * K * 2;
    const size_t tstep = 2 * hstep;
    const size_t hstepB = Epi::PERM ? (size_t)32 * K * 2 : hstep;
    const unsigned ldsw = (unsigned)wid * 1024u;
    const int aoff = lds_byte(wr * 64 + fr, fq * 8), boff = lds_byte(wc * 32 + fr, fq * 8);
#define PG8_SA(b, h) (((b) * 2 + (h)) * HTB)
#define PG8_SB(b, h) ((4 + (b) * 2 + (h)) * HTB)
#define PG8_STAGE(bufoff, gbase, voff) do { _Pragma("unroll") for (int _i = 0; _i < 2; ++_i) \
        __builtin_amdgcn_global_load_lds((const unsigned*)((const char*)(gbase) + (voff)[_i]), (PG8_LAS unsigned*)(lds + (bufoff) + ldsw + _i * 8192), 16, 0, 0); } while (0)
#define PG8_LDA(dst, b, h) do { _Pragma("unroll") for (int m = 0; m < 4; ++m) _Pragma("unroll") for (int k = 0; k < 2; ++k) dst[m][k] = *(const PG8_LAS bf16x8*)(lds + PG8_SA(b, h) + aoff + m * 2048 + k * 1024); } while (0)
#define PG8_LDB(dst, b, h) do { _Pragma("unroll") for (int n = 0; n < 2; ++n) _Pragma("unroll") for (int k = 0; k < 2; ++k) dst[n][k] = *(const PG8_LAS bf16x8*)(lds + PG8_SB(b, h) + boff + n * 2048 + k * 1024); } while (0)
#define PG8_MMA(ai, bj, At, Bt) do { __builtin_amdgcn_s_setprio(1); _Pragma("unroll") for (int m = 0; m < 4; ++m) _Pragma("unroll") for (int n = 0; n < 2; ++n) _Pragma("unroll") for (int k = 0; k < 2; ++k) \
        acc[ai][bj][m][n] = __builtin_amdgcn_mfma_f32_16x16x32_bf16(Bt[n][k], At[m][k], acc[ai][bj][m][n], 0, 0, 0); __builtin_amdgcn_s_setprio(0); } while (0)
#define PG8_WAIT_V(n) asm volatile("s_waitcnt vmcnt(" #n ")" ::: "memory")
#define PG8_WAIT_L(n) asm volatile("s_waitcnt lgkmcnt(" #n ")" ::: "memory")
#define PG8_BAR __builtin_amdgcn_s_barrier()
#define PG8_SCHED __builtin_amdgcn_sched_barrier(0)
    Unit cur, nxt; int ui = 0;
    if (!S.next(0, cur)) return;
    f32x4 acc[2][2][4][2];
#pragma unroll
    for (int a = 0; a < 2; ++a)
#pragma unroll
        for (int b = 0; b < 2; ++b)
#pragma unroll
            for (int m = 0; m < 4; ++m)
#pragma unroll
                for (int n = 0; n < 2; ++n) acc[a][b][m][n] = (f32x4){0.f, 0.f, 0.f, 0.f};
    bf16x8 At[4][2], B0[2][2], B1[2][2];
    const char* cA = (const char*)g.A + (size_t)cur.pm * tstep; const char* cB = (const char*)g.Bt + (size_t)cur.pn * tstep;
    S.a_ready(cur);
    if constexpr (SP2) {
        PG8_STAGE(PG8_SB(0, 0), cB, voffB); PG8_STAGE(PG8_SB(0, 1), cB + hstepB, voffB); PG8_STAGE(PG8_SA(0, 0), cA, voffA); PG8_STAGE(PG8_SA(0, 1), cA + hstep, voffA);
        if (wr == 1) PG8_BAR;
        PG8_WAIT_V(2); PG8_BAR;
        PG8_STAGE(PG8_SB(1, 0), cB + kstep, voffB); PG8_STAGE(PG8_SA(1, 0), cA + kstep, voffA); PG8_STAGE(PG8_SB(1, 1), cB + hstepB + kstep, voffB);
        PG8_WAIT_V(6); PG8_BAR;
    } else {
        PG8_STAGE(PG8_SB(0, 0), cB, voffB); PG8_STAGE(PG8_SA(0, 0), cA, voffA); PG8_STAGE(PG8_SB(0, 1), cB + hstepB, voffB); PG8_STAGE(PG8_SA(0, 1), cA + hstep, voffA);
        if (wr == 1) PG8_BAR;
        PG8_WAIT_V(4); PG8_BAR;
        PG8_STAGE(PG8_SB(1, 0), cB + kstep, voffB); PG8_STAGE(PG8_SA(1, 0), cA + kstep, voffA); PG8_STAGE(PG8_SB(1, 1), cB + hstepB + kstep, voffB);
        PG8_WAIT_V(6); PG8_BAR;
    }
    for (;;) {
        const bool has_next = S.next(ui + 1, nxt);
        const char* nA = has_next ? (const char*)g.A + (size_t)nxt.pm * tstep : cA; const char* nB = has_next ? (const char*)g.Bt + (size_t)nxt.pn * tstep : cB;
        for (int t = 0; t < nt; t += 2) {
            const bool last = (t == nt - 2);
            const char* a1 = cA + (size_t)(t + 1) * kstep;
            const char* a2 = last ? nA : cA + (size_t)(t + 2) * kstep; const char* b2 = last ? nB : cB + (size_t)(t + 2) * kstep;
            const char* a3 = a2 + kstep; const char* b3 = b2 + kstep;
            if (last && has_next) S.a_ready(nxt);
            if constexpr (SP2) {
            PG8_LDB(B0, 0, 0); PG8_LDB(B1, 0, 1); PG8_SCHED; PG8_LDA(At, 0, 0); PG8_STAGE(PG8_SA(1, 1), a1 + hstep, voffA);
            PG8_WAIT_V(8); PG8_WAIT_L(0); PG8_BAR; PG8_MMA(0, 0, At, B0); PG8_MMA(0, 1, At, B1); PG8_BAR; PG8_SCHED;
            PG8_LDA(At, 0, 1); PG8_STAGE(PG8_SB(0, 0), b2, voffB); PG8_STAGE(PG8_SB(0, 1), b2 + hstepB, voffB); PG8_STAGE(PG8_SA(0, 0), a2, voffA);
            PG8_WAIT_V(8); PG8_WAIT_L(0); PG8_BAR; PG8_MMA(1, 0, At, B0); PG8_MMA(1, 1, At, B1); PG8_BAR; PG8_SCHED;
            PG8_LDB(B0, 1, 0); PG8_LDB(B1, 1, 1); PG8_SCHED; PG8_LDA(At, 1, 0); PG8_STAGE(PG8_SA(0, 1), a2 + hstep, voffA);
            PG8_WAIT_V(8); PG8_WAIT_L(0); PG8_BAR; PG8_MMA(0, 0, At, B0); PG8_MMA(0, 1, At, B1); PG8_BAR; PG8_SCHED;
            PG8_LDA(At, 1, 1); PG8_STAGE(PG8_SB(1, 0), b3, voffB); PG8_STAGE(PG8_SB(1, 1), b3 + hstepB, voffB); PG8_STAGE(PG8_SA(1, 0), a3, voffA);
            PG8_WAIT_V(8); PG8_WAIT_L(0); PG8_BAR; PG8_MMA(1, 0, At, B0); PG8_MMA(1, 1, At, B1); PG8_BAR; PG8_SCHED;
            } else {
            PG8_LDB(B0, 0, 0); PG8_SCHED; PG8_LDA(At, 0, 0); PG8_STAGE(PG8_SA(1, 1), a1 + hstep, voffA);
            PG8_WAIT_L(8); PG8_BAR; PG8_WAIT_L(0); PG8_MMA(0, 0, At, B0); PG8_BAR; PG8_SCHED;
            PG8_LDB(B1, 0, 1); PG8_STAGE(PG8_SB(0, 0), b2, voffB);
            PG8_BAR; PG8_WAIT_L(0); PG8_MMA(0, 1, At, B1); PG8_BAR;
            PG8_LDA(At, 0, 1); PG8_STAGE(PG8_SA(0, 0), a2, voffA);
            PG8_BAR; PG8_WAIT_L(0); PG8_MMA(1, 0, At, B0); PG8_BAR; PG8_SCHED;
            PG8_STAGE(PG8_SB(0, 1), b2 + hstepB, voffB);
            PG8_WAIT_V(6); PG8_BAR; PG8_MMA(1, 1, At, B1); PG8_BAR;
            PG8_LDB(B0, 1, 0); PG8_SCHED; PG8_LDA(At, 1, 0); PG8_STAGE(PG8_SA(0, 1), a2 + hstep, voffA);
            PG8_WAIT_L(8); PG8_BAR; PG8_WAIT_L(0); PG8_MMA(0, 0, At, B0); PG8_BAR; PG8_SCHED;
            PG8_LDB(B1, 1, 1); PG8_STAGE(PG8_SB(1, 0), b3, voffB);
            PG8_BAR; PG8_WAIT_L(0); PG8_MMA(0, 1, At, B1); PG8_BAR;
            PG8_LDA(At, 1, 1); PG8_STAGE(PG8_SA(1, 0), a3, voffA);
            PG8_BAR; PG8_WAIT_L(0); PG8_MMA(1, 0, At, B0); PG8_BAR; PG8_SCHED;
            PG8_STAGE(PG8_SB(1, 1), b3 + hstepB, voffB);
            PG8_WAIT_V(6); PG8_BAR; PG8_MMA(1, 1, At, B1); PG8_BAR;
            }
        }
        if constexpr (ALIGN_EPI) { if (wr == 0) PG8_BAR; }
        if constexpr (!Epi::AFTER_DRAIN) { E(acc, cur, wr, wc, fr, fq); S.done(cur); }
        if (!has_next) break;
#pragma unroll
        for (int a = 0; a < 2; ++a)
#pragma unroll
            for (int b = 0; b < 2; ++b)
#pragma unroll
                for (int m = 0; m < 4; ++m)
#pragma unroll
                    for (int n = 0; n < 2; ++n) acc[a][b][m][n] = (f32x4){0.f, 0.f, 0.f, 0.f};
        cur = nxt; cA = nA; cB = nB; ++ui;
        if constexpr (ALIGN_EPI) { if (wr == 1) PG8_BAR; }
    }
    PG8_WAIT_V(0);
    if constexpr (!ALIGN_EPI) { if (wr == 0) PG8_BAR; }
    PG8_BAR;
    if constexpr (Epi::AFTER_DRAIN) { E.fused(acc, cur, wr, wc, fr, fq, lds, wid, lane); S.done(cur); }
#undef PG8_SA
#undef PG8_SB
#undef PG8_STAGE
#undef PG8_LDA
#undef PG8_LDB
#undef PG8_MMA
#undef PG8_WAIT_V
#undef PG8_WAIT_L
#undef PG8_BAR
#undef PG8_SCHED
}
}

constexpr int NWAVES = 8;
constexpr int NWG = 256;
constexpr int BATCH = 2, T = 4096, DM = 4096, DEPTH = 2, M = BATCH * T, FF = 4 * DM;
constexpr int NIN_ORIG = 10976, NIN = 11008;
constexpr int C_RQ = 0, C_RK = 512, C_RV = 1024, C_RG = 2048, C_DQ = 3072, C_DK = 4608, C_DV = 5120, C_IQ = 5632, C_IK = 9728, C_IW = 9856,
              C_KR = 9888, C_PAD = 9952, C_CQ = 9984, C_CKV = 10752;
constexpr int O_CQ = 9888, O_CKV = 10656, O_KR = 10912;
constexpr int QL = 768, KVL = 256, NUQ = 2304, NUKV = 3072;
constexpr int MIXW = 4096, MIX_RET = 0, MIX_DSA = 1024, MIX_MLA = 2560;
constexpr float NORM_EPS = 1e-6f;
constexpr int TOPK = 256;

constexpr size_t MiB = 1u << 20;
constexpr size_t WS_CTL = 0, CTL_ZERO_BYTES = 1 * MiB;
constexpr size_t WS_TABA = 1 * MiB;
constexpr size_t WS_TABB = 2 * MiB;
constexpr size_t WS_W = 4 * MiB;
constexpr size_t SZ_WIN = (size_t)NIN * DM * 2, SZ_WUQ = (size_t)NUQ * QL * 2, SZ_WUKV = (size_t)NUKV * KVL * 2, SZ_WO = (size_t)DM * MIXW * 2, SZ_WUP = (size_t)FF * DM * 2, SZ_WDN = (size_t)DM * FF * 2;
constexpr size_t OFF_WIN = 0, OFF_WUQ = OFF_WIN + SZ_WIN, OFF_WUKV = OFF_WUQ + SZ_WUQ, OFF_WO = OFF_WUKV + SZ_WUKV, OFF_WUP = OFF_WO + SZ_WO, OFF_WDN = OFF_WUP + SZ_WUP, SZ_WLAYER = OFF_WDN + SZ_WDN;
constexpr size_t WS_H = WS_W + 2 * SZ_WLAYER;
constexpr size_t WS_U = WS_H + (size_t)M * DM * 4;
constexpr size_t WS_PROJ = WS_U + (size_t)M * DM * 2;
constexpr size_t WS_CQN = WS_PROJ + (size_t)M * NIN * 2;
constexpr size_t WS_CKVN = WS_CQN + (size_t)M * QL * 2;
constexpr size_t WS_QMLA = WS_CKVN + (size_t)M * KVL * 2;
constexpr size_t WS_KVMLA = WS_QMLA + (size_t)M * NUQ * 2;
constexpr size_t WS_MIX = WS_KVMLA + (size_t)M * NUKV * 2;
constexpr size_t WS_HID = WS_MIX + (size_t)M * MIXW * 2;
constexpr size_t WS_SEL = WS_HID + (size_t)M * FF * 2;
constexpr size_t WS_ISC = WS_SEL + (size_t)M * TOPK * 4;
constexpr size_t WS_DKC = WS_ISC + (size_t)M * T * 4;
constexpr size_t WS_DVC = WS_DKC + (size_t)M * 512 * 2;
constexpr size_t WS_IKC = WS_DVC + (size_t)M * 512 * 2;
constexpr size_t WS_BU = WS_IKC + (size_t)M * 128 * 2;
constexpr size_t WS_END = WS_BU + (size_t)BATCH * 8 * 16 * 64 * 128 * 4;
static_assert(SZ_WLAYER % 256 == 0 && WS_H % 256 == 0 && WS_PROJ % 256 == 0 && WS_CQN % 256 == 0 && WS_QMLA % 256 == 0 && WS_SEL % 256 == 0, "alignment");

constexpr int CW_TMO = 0, CW_CODE = 1, CW_BAR = 4096;
constexpr int CW_ROWSS = 65536;

constexpr int RING_OFF = 0, RING_BYTES = 131072;
constexpr int LDSCTL_OFF = RING_BYTES, MISC_OFF = LDSCTL_OFF + 320;
constexpr int LDS_BYTES = 163840;
constexpr int XTRA_OFF = RING_BYTES + 1024, XTRA_WAVE = 3968;

#define GAS __attribute__((address_space(1)))
#define LAS __attribute__((address_space(3)))
typedef unsigned short bf16;
typedef unsigned v4u __attribute__((ext_vector_type(4)));
typedef unsigned v2u __attribute__((ext_vector_type(2)));
typedef float f32x4 __attribute__((ext_vector_type(4)));
typedef float f32x2 __attribute__((ext_vector_type(2)));
typedef GAS unsigned gu32;
#define RLX_AGENT __ATOMIC_RELAXED, __HIP_MEMORY_SCOPE_AGENT
#define LDS_WAIT() asm volatile("s_waitcnt lgkmcnt(0)" ::: "memory")
#define VM_WAIT() asm volatile("s_waitcnt vmcnt(0)" ::: "memory")
__device__ __forceinline__ unsigned f2bf(float f) { unsigned u = __builtin_bit_cast(unsigned, f); return (u + 0x7fffu + ((u >> 16) & 1u)) >> 16; }
__device__ __forceinline__ unsigned pk2(float lo, float hi) { return f2bf(lo) | (f2bf(hi) << 16); }
__device__ __forceinline__ float bf2f(unsigned short b) { return __builtin_bit_cast(float, (unsigned)b << 16); }
__device__ __forceinline__ float bflo(unsigned w) { return __builtin_bit_cast(float, w << 16); }
__device__ __forceinline__ float bfhi(unsigned w) { return __builtin_bit_cast(float, w & 0xffff0000u); }
__device__ __forceinline__ float wave_sum(float v) {
#pragma unroll
    for (int o = 1; o < 64; o <<= 1) v += __shfl_xor(v, o);
    return v;
}
__device__ __forceinline__ float wave_max(float v) {
#pragma unroll
    for (int o = 1; o < 64; o <<= 1) v = fmaxf(v, __shfl_xor(v, o));
    return v;
}
__device__ __forceinline__ float rdlane(float v, int l) { return __builtin_bit_cast(float, __builtin_amdgcn_readlane(__builtin_bit_cast(int, v), l)); }

#define XB_TMO      128
#define XB_XCNT(j)  (256  + 64 * (j))
#define XB_XSUB(j)  (1280 + 64 * (j))
#define XB_XGEN(j)  (2304 + 64 * (j))
#define XB_TOP      3328
#define XB_TOPGEN   3392
#define XCD_BAR_WORDS 3456
#define XB_SPIN_CAP (1u << 22)

__device__ __forceinline__ unsigned xb_ld(unsigned* p)              { return __hip_atomic_load(p, __ATOMIC_RELAXED, __HIP_MEMORY_SCOPE_AGENT); }
__device__ __forceinline__ unsigned xb_add(unsigned* p, unsigned v) { return __hip_atomic_fetch_add(p, v, __ATOMIC_RELAXED, __HIP_MEMORY_SCOPE_AGENT); }
__device__ __forceinline__ unsigned xb_xcc_id() { return (unsigned)__builtin_amdgcn_s_getreg((3 << 11) | 20) & 0xFu; }
#define XB_SPIN(cond, bar) do { unsigned _sp = 0; while (cond) { __builtin_amdgcn_s_sleep(1); \
    if ((++_sp & 255u) == 0u) { if (xb_ld(&(bar)[XB_TMO])) break; if (_sp > XB_SPIN_CAP) { atomicAdd(&(bar)[XB_TMO], 1u); break; } } } } while (0)

struct XcdBarrier {
    unsigned* bar; unsigned x;
    volatile LAS unsigned* st;
};

__device__ __forceinline__ XcdBarrier xcd_barrier_post(unsigned* bar, volatile LAS unsigned* st) {
    XcdBarrier b; b.bar = bar; b.x = xb_xcc_id(); b.st = st;
    if (threadIdx.x == 0) (void)xb_add(&bar[XB_XCNT(b.x)], 1u);
    return b;
}
__device__ __forceinline__ void xcd_barrier_complete(unsigned* bar, unsigned x, unsigned& nloc, unsigned& nx) {
    const unsigned G = 256u;
    unsigned sum, cnt, mine, sp = 0u;
    for (;;) {
        sum = 0u; cnt = 0u; mine = 0u;
#pragma unroll
        for (unsigned j = 0; j < 16; ++j) { const unsigned c = xb_ld(&bar[XB_XCNT(j)]); sum += c; cnt += (c > 0u) ? 1u : 0u; mine = (j == x) ? c : mine; }
        if (sum == G) break;
        __builtin_amdgcn_s_sleep(1);
        if ((++sp & 255u) == 0u) { if (xb_ld(&bar[XB_TMO])) break; if (sp > XB_SPIN_CAP) { atomicAdd(&bar[XB_TMO], 1u); break; } }
    }
    nloc = mine > 0u ? mine : 1u; nx = cnt > 0u ? cnt : 1u;
}

__device__ __forceinline__ void xcd_barrier(const XcdBarrier& b, const int tid) {
    asm volatile("s_waitcnt vmcnt(0)" ::: "memory");
    __syncthreads();
    if (tid == 0) {
        unsigned* bar = b.bar;
        __builtin_amdgcn_s_waitcnt(0);
        unsigned nloc = b.st[0], nx = b.st[1];
        if (nloc == 0u) { xcd_barrier_complete(bar, b.x, nloc, nx); b.st[0] = nloc; b.st[1] = nx; }
        const unsigned old = xb_add(&bar[XB_XSUB(b.x)], 1u);
        const unsigned gen = old / nloc;
        if (old + 1u == (gen + 1u) * nloc) {
            __builtin_amdgcn_fence(__ATOMIC_RELEASE, "agent");
            asm volatile("s_waitcnt vmcnt(0)" ::: "memory");
            const unsigned og = xb_add(&bar[XB_TOP], 1u);
            const unsigned tg = og / nx;
            if (og + 1u == (tg + 1u) * nx) xb_add(&bar[XB_TOPGEN], 1u);
            else XB_SPIN(xb_ld(&bar[XB_TOPGEN]) == tg, bar);
            __builtin_amdgcn_fence(__ATOMIC_ACQUIRE, "agent");
            xb_add(&bar[XB_XGEN(b.x)], 1u);
            asm volatile("s_waitcnt vmcnt(0)" ::: "memory");
        } else {
            XB_SPIN(xb_ld(&bar[XB_XGEN(b.x)]) == gen, bar);
            __builtin_amdgcn_fence(__ATOMIC_ACQUIRE, "agent");
            asm volatile("s_waitcnt vmcnt(0)" ::: "memory");
        }
    }
    __syncthreads();
}


__device__ __forceinline__ int lane_now() { int l; asm volatile("v_mbcnt_lo_u32_b32 %0, -1, 0\n\tv_mbcnt_hi_u32_b32 %0, -1, %0" : "=v"(l)); return l; }
__device__ __forceinline__ int tid_now(int wave_s) { return wave_s * 64 + lane_now(); }
template <int OFF> __device__ __forceinline__ unsigned long long karg_u64() {
    unsigned long long v; const unsigned long long ka = (unsigned long long)__builtin_amdgcn_kernarg_segment_ptr();
    asm volatile("s_load_dwordx2 %0, %1, %2\n\ts_waitcnt lgkmcnt(0)" : "=s"(v) : "s"(ka), "i"(OFF) : "memory");
    return v;
}
#define KA_IN(i) ((const float*)(const GAS float*)karg_u64<8 * (i)>())
#define KA_OUT() ((float*)(GAS float*)karg_u64<96>())
#define KA_WS() ((unsigned char*)(GAS unsigned char*)karg_u64<104>())
struct Frame {
    LAS unsigned char* lds;
    unsigned char* ws;
    int lane, wave, gw, NGW;
};
__device__ __forceinline__ Frame make_frame(LAS unsigned char* lds, int wave_s) {
    Frame F; F.lds = lds; F.ws = KA_WS(); F.lane = lane_now(); F.wave = wave_s;
    F.gw = blockIdx.x * NWAVES + F.wave; F.NGW = NWG * NWAVES; return F;
}

struct TItem { f32x4 r[8]; f32x4 g[2]; };
__device__ __forceinline__ unsigned cvtpk_t(float lo, float hi) { typedef float f2_t __attribute__((ext_vector_type(2))); typedef __bf16 b2_t __attribute__((ext_vector_type(2))); f2_t v = {lo, hi}; b2_t b = __builtin_convertvector(v, b2_t); return __builtin_bit_cast(unsigned, b); }
__device__ __forceinline__ void titem_load(TItem& t, const float* W, int ldw, int c0, int k0, int lane, const float* gain) {
    const int kr = lane >> 3, c4 = lane & 7;
#pragma unroll
    for (int i = 0; i < 8; ++i) t.r[i] = __builtin_nontemporal_load((const GAS f32x4*)(W + (size_t)(k0 + 8 * kr + i) * ldw + c0 + 4 * c4));
    if (gain) { t.g[0] = *(const GAS f32x4*)(gain + k0 + 8 * kr); t.g[1] = *(const GAS f32x4*)(gain + k0 + 8 * kr + 4); }
}
__device__ __forceinline__ void titem_store(const TItem& t, int k0, bf16* WT, int K, int r0, LAS float* scr, int lane, bool has_gain) {
    const int kr = lane >> 3, c4 = lane & 7; (void)scr;
    GAS v4u* o = (GAS v4u*)(WT + (size_t)(r0 + 4 * c4) * K + k0 + 8 * kr);
#pragma unroll
    for (int e = 0; e < 4; ++e) {
        v4u w;
        if (has_gain) { w.x = cvtpk_t(t.r[0][e] * t.g[0].x, t.r[1][e] * t.g[0].y); w.y = cvtpk_t(t.r[2][e] * t.g[0].z, t.r[3][e] * t.g[0].w);
                        w.z = cvtpk_t(t.r[4][e] * t.g[1].x, t.r[5][e] * t.g[1].y); w.w = cvtpk_t(t.r[6][e] * t.g[1].z, t.r[7][e] * t.g[1].w); }
        else { w.x = cvtpk_t(t.r[0][e], t.r[1][e]); w.y = cvtpk_t(t.r[2][e], t.r[3][e]); w.z = cvtpk_t(t.r[4][e], t.r[5][e]); w.w = cvtpk_t(t.r[6][e], t.r[7][e]); }
        *(GAS v4u*)((GAS unsigned char*)o + (size_t)e * K * 2) = w; }
}
template <int NIF = 3>
__device__ __forceinline__ void transpose_seg(Frame& F, long& base, const float* W, int ldw, int K, int c0, int ncols, bf16* WT, int r0, LAS float* scr, const float* gain = nullptr) {
    const int nblk = ncols / 32, nit = (K / 64) * nblk;
    long first = ((long)__builtin_amdgcn_readfirstlane(F.gw) - base) % F.NGW; if (first < 0) first += F.NGW;
    TItem t[NIF]; const long st = F.NGW; long it[NIF];
#pragma unroll
    for (int q = 0; q < NIF; ++q) { it[q] = first + q * st; if (it[q] < nit) titem_load(t[q], W, ldw, c0 + 32 * (int)(it[q] % nblk), 64 * (int)(it[q] / nblk), F.lane, gain); }
    while (it[0] < nit) {
#pragma unroll
        for (int q = 0; q < NIF; ++q) if (it[q] < nit) {
            titem_store(t[q], 64 * (int)(it[q] / nblk), WT, K, r0 + 32 * (int)(it[q] % nblk), scr, F.lane, gain != nullptr); it[q] += NIF * st;
            if (it[q] < nit) titem_load(t[q], W, ldw, c0 + 32 * (int)(it[q] % nblk), 64 * (int)(it[q] / nblk), F.lane, gain); }
    }
    base += nit;
}
__device__ __forceinline__ void rms_row_to_f32(const float* xrow, const float* g, float* orow, int lane) {
    const GAS f32x4* xr = (const GAS f32x4*)xrow + lane; const GAS f32x4* gr = (const GAS f32x4*)g + lane;
    f32x4 v[16]; float s = 0.f;
#pragma unroll
    for (int j = 0; j < 16; ++j) { v[j] = __builtin_nontemporal_load(xr + 64 * j); s += (v[j].x * v[j].x + v[j].y * v[j].y) + (v[j].z * v[j].z + v[j].w * v[j].w); }
    const float rstd = 1.f / sqrtf(wave_sum(s) * (1.f / DM) + NORM_EPS);
    GAS f32x4* o = (GAS f32x4*)orow + lane;
#pragma unroll
    for (int j = 0; j < 16; ++j) { const f32x4 gg = gr[64 * j]; __builtin_nontemporal_store((v[j] * rstd) * gg, o + 64 * j); }
}

__host__ __device__ constexpr int inproj_gemm_wgs(int G) { const int nwg = (M / 256) * (NIN / 256), rounds = (nwg + G - 1) / G; return (nwg + rounds - 1) / rounds; }
__device__ __forceinline__ void side_convert(LAS unsigned char* lds, const int wave_s, int l, int rank, int H) {
    Frame F = make_frame(lds, wave_s); F.gw = rank * NWAVES + F.wave; F.NGW = H * NWAVES;
    LAS float* scr = (LAS float*)(F.lds + RING_OFF + F.wave * 16384);
    unsigned char* wl = F.ws + WS_W + (size_t)l * SZ_WLAYER; const float* g_mlp = KA_IN(8) + (size_t)l * DM; long base = 0;
    transpose_seg(F, base, KA_IN(7) + (size_t)l * MIXW * DM, DM, MIXW, 0, DM, (bf16*)(wl + OFF_WO), 0, scr);
    transpose_seg(F, base, KA_IN(9) + (size_t)l * DM * FF, FF, DM, 0, FF, (bf16*)(wl + OFF_WUP), 0, scr, g_mlp);
}
template <int NIF>
__device__ __forceinline__ void convert_front(Frame& F, long& base, int l) {
    unsigned char* wl = F.ws + WS_W + (size_t)l * SZ_WLAYER; LAS float* scr = nullptr;
    const float* w_in = KA_IN(2) + (size_t)l * DM * NIN_ORIG; const float* g_attn = KA_IN(1) + (size_t)l * DM;
    bf16* WinT = (bf16*)(wl + OFF_WIN);
    transpose_seg<NIF>(F, base, w_in, NIN_ORIG, DM, 0, O_CQ, WinT, 0, scr, g_attn);
    transpose_seg<NIF>(F, base, w_in, NIN_ORIG, DM, O_CQ, QL + KVL, WinT, C_CQ, scr, g_attn);
    transpose_seg<NIF>(F, base, w_in, NIN_ORIG, DM, O_KR, 64, WinT, C_KR, scr, g_attn);
    transpose_seg<NIF>(F, base, KA_IN(5) + (size_t)l * QL * NUQ, NUQ, QL, 0, NUQ, (bf16*)(wl + OFF_WUQ), 0, scr);
    transpose_seg<NIF>(F, base, KA_IN(6) + (size_t)l * KVL * NUKV, NUKV, KVL, 0, NUKV, (bf16*)(wl + OFF_WUKV), 0, scr);
    { unsigned z = 0u; asm volatile("" : "+v"(z));
      for (int i = F.gw * 64 + F.lane; i < 32 * DM * 2 / 16; i += F.NGW * 64) ((GAS v4u*)(WinT + (size_t)C_PAD * DM))[i] = (v4u){z, z, z, z}; }
}
constexpr int ATT_CONV = 128;
__device__ __forceinline__ void wdn_convert(LAS unsigned char* lds, const int wave_s, int l, int rank) {
    Frame F = make_frame(lds, wave_s); F.gw = rank * NWAVES + F.wave; F.NGW = ATT_CONV * NWAVES;
    unsigned char* wl = F.ws + WS_W + (size_t)l * SZ_WLAYER; long base = 0;
    transpose_seg<5>(F, base, KA_IN(10) + (size_t)l * FF * DM, DM, FF, 0, DM, (bf16*)(wl + OFF_WDN), 0, (LAS float*)nullptr);
    if (l + 1 < DEPTH) convert_front<5>(F, base, l + 1);
}
__device__ __forceinline__ void p0_prologue(LAS unsigned char* lds, const int wave_s) {
    Frame F = make_frame(lds, wave_s);
    LAS float* scr = (LAS float*)(F.lds + RING_OFF + F.wave * 16384);
    long base = 0;
    convert_front<3>(F, base, 0);
    {
        float2* tabA = (float2*)(F.ws + WS_TABA); float2* tabB = (float2*)(F.ws + WS_TABB);
        const int gt = F.gw * 64 + F.lane, NT = F.NGW * 64;
        for (int i = gt; i < T * 32; i += NT) { const int t = i >> 5, k = i & 31; const float inv = expf((-9.210340371976184f * (float)k) * (2.0f / 64.0f)); const float ang = (float)t * inv; tabA[i] = make_float2(cosf(ang), sinf(ang)); }
        for (int i = gt; i < T * 16; i += NT) { const int t = i >> 4, k = i & 15; const float inv = expf((-13.122363377404328f * (float)k) * (2.0f / 32.0f)); const float ang = (float)t * inv; tabB[i] = make_float2(cosf(ang), sinf(ang)); }
    }
    { const float* x = KA_IN(0); float* rss = (float*)(F.ws + WS_CTL) + CW_ROWSS;
      for (int m = F.gw; m < M; m += F.NGW) {
          const GAS f32x4* xr = (const GAS f32x4*)(x + (size_t)m * DM) + F.lane; GAS v2u* o8 = (GAS v2u*)((bf16*)(F.ws + WS_U) + (size_t)m * DM) + F.lane; float sq = 0.f;
#pragma unroll
          for (int j = 0; j < 16; ++j) { const f32x4 v = __builtin_nontemporal_load(xr + 64 * j); sq += (v.x * v.x + v.y * v.y) + (v.z * v.z + v.w * v.w); v2u o; o.x = pk2(v.x, v.y); o.y = pk2(v.z, v.w); o8[64 * j] = o; }
          sq = wave_sum(sq); if (F.lane == 0) rss[m] = sq; } }
}

__device__ __forceinline__ v4u rope_chunk(v4u own, v4u par, const float2* tab8, float sg, float scale) {
    const GAS f32x4* tp = (const GAS f32x4*)tab8; unsigned ow[4] = {own.x, own.y, own.z, own.w}, pw[4] = {par.x, par.y, par.z, par.w};
#pragma unroll
    for (int jj = 0; jj < 4; ++jj) { const f32x4 cs = tp[jj];
        ow[jj] = pk2((bflo(ow[jj]) * cs.x + sg * bflo(pw[jj]) * cs.y) * scale, (bfhi(ow[jj]) * cs.z + sg * bfhi(pw[jj]) * cs.w) * scale); }
    return (v4u){ow[0], ow[1], ow[2], ow[3]};
}
__device__ __forceinline__ void prep_phase(LAS unsigned char* lds, const int wave_s, int layer) {
    Frame F = make_frame(lds, wave_s);
    bf16* proj = (bf16*)(F.ws + WS_PROJ); bf16* cqn = (bf16*)(F.ws + WS_CQN); bf16* ckvn = (bf16*)(F.ws + WS_CKVN);
    const float2* tabA = (const float2*)(F.ws + WS_TABA); const float2* tabB = (const float2*)(F.ws + WS_TABB);
    const float* gq = KA_IN(3) + (size_t)layer * QL; const float* gkv = KA_IN(4) + (size_t)layer * KVL;
    const int lane = F.lane;
    for (int m = F.gw; m < M; m += F.NGW) {
        const int t = m & (T - 1), bb = m / T; bf16* row = proj + (size_t)m * NIN; const float2* ta = tabA + t * 32; const float2* tb = tabB + t * 16;
        GAS v4u* rq = (GAS v4u*)(row + C_RQ); GAS v4u* rk = (GAS v4u*)(row + C_RK); GAS v4u* kr = (GAS v4u*)(row + C_KR);
        const v4u rq_o = rq[lane], rq_p = rq[lane ^ 4], rk_o = rk[lane], rk_p = rk[lane ^ 4];
        const int dh = lane >> 2, dc = lane & 3;
        GAS v4u* dqp = (GAS v4u*)(row + C_DQ + (lane < 48 ? dh : 0) * 128);
        const v4u dq_o = dqp[dc], dq_p = dqp[dc ^ 2];
        GAS v4u* iq0 = (GAS v4u*)(row + C_IQ + dh * 128); GAS v4u* iq1 = (GAS v4u*)(row + C_IQ + (16 + dh) * 128);
        const v4u i0_o = iq0[dc], i0_p = iq0[dc ^ 2], i1_o = iq1[dc], i1_p = iq1[dc ^ 2];
        const v4u kr_o = kr[lane & 7], kr_p = kr[(lane & 7) ^ 4];
        const int n = lane >> 4, c = lane & 15;
        const GAS v4u* dks = (const GAS v4u*)(row + C_DK + n * 128); const GAS v4u* iks = (const GAS v4u*)(row + C_IK);
        v4u dk_o = dks[c]; const v4u dk_p = dks[c < 4 ? (c ^ 2) : c]; v4u ik_o = iks[c]; const v4u ik_p = iks[c < 4 ? (c ^ 2) : c];
        const v4u dv_o = ((const GAS v4u*)(row + C_DV + n * 128))[c];
        const GAS v4u* cqs = (const GAS v4u*)(row + C_CQ); const v4u cq0 = cqs[lane], cq1 = cqs[64 + (lane & 31)]; const v4u ckv0 = ((const GAS v4u*)(row + C_CKV))[lane & 31];
        { const int c8 = lane & 7; const float sg = (c8 < 4) ? -1.f : 1.f; const float2* tq = ta + (c8 & 3) * 8;
          rq[lane] = rope_chunk(rq_o, rq_p, tq, sg, 1.f); rk[lane] = rope_chunk(rk_o, rk_p, tq, sg, 0.125f);
          if (lane < 8) kr[lane] = rope_chunk(kr_o, kr_p, tq, sg, 1.f); }
        { const float sg = (dc < 2) ? -1.f : 1.f; const float2* tq = tb + (dc & 1) * 8;
          if (lane < 48) dqp[dc] = rope_chunk(dq_o, dq_p, tq, sg, 1.f);
          iq0[dc] = rope_chunk(i0_o, i0_p, tq, sg, 1.f); iq1[dc] = rope_chunk(i1_o, i1_p, tq, sg, 1.f); }
        { if (c < 4) { const float sg = (c < 2) ? -1.f : 1.f; const float2* tq = tb + (c & 1) * 8; dk_o = rope_chunk(dk_o, dk_p, tq, sg, 1.f); ik_o = rope_chunk(ik_o, ik_p, tq, sg, 1.f); }
          const size_t di = (((size_t)(bb * 4 + n)) * T + t) * 128 + c * 8;
          *(GAS v4u*)((bf16*)(F.ws + WS_DKC) + di) = dk_o;
          *(GAS v4u*)((bf16*)(F.ws + WS_DVC) + di) = dv_o;
          if (lane < 16) *(GAS v4u*)((bf16*)(F.ws + WS_IKC) + (size_t)m * 128 + c * 8) = ik_o; }
        { const unsigned w0[4] = {cq0.x, cq0.y, cq0.z, cq0.w}, w1[4] = {cq1.x, cq1.y, cq1.z, cq1.w}; float sq = 0.f, sq1 = 0.f;
#pragma unroll
          for (int jj = 0; jj < 4; ++jj) { sq += bflo(w0[jj]) * bflo(w0[jj]) + bfhi(w0[jj]) * bfhi(w0[jj]); sq1 += bflo(w1[jj]) * bflo(w1[jj]) + bfhi(w1[jj]) * bfhi(w1[jj]); }
          if (lane < 32) sq += sq1;
          const float rstd = 1.f / sqrtf(wave_sum(sq) * (1.f / QL) + NORM_EPS);
          { const GAS f32x4* gp = (const GAS f32x4*)(gq + 8 * lane); const f32x4 ga = gp[0], gb = gp[1]; v4u o;
            o.x = pk2(bflo(w0[0]) * rstd * ga.x, bfhi(w0[0]) * rstd * ga.y); o.y = pk2(bflo(w0[1]) * rstd * ga.z, bfhi(w0[1]) * rstd * ga.w);
            o.z = pk2(bflo(w0[2]) * rstd * gb.x, bfhi(w0[2]) * rstd * gb.y); o.w = pk2(bflo(w0[3]) * rstd * gb.z, bfhi(w0[3]) * rstd * gb.w);
            *(GAS v4u*)(cqn + (size_t)m * QL + 8 * lane) = o; }
          if (lane < 32) { const GAS f32x4* gp = (const GAS f32x4*)(gq + 512 + 8 * lane); const f32x4 ga = gp[0], gb = gp[1]; v4u o;
            o.x = pk2(bflo(w1[0]) * rstd * ga.x, bfhi(w1[0]) * rstd * ga.y); o.y = pk2(bflo(w1[1]) * rstd * ga.z, bfhi(w1[1]) * rstd * ga.w);
            o.z = pk2(bflo(w1[2]) * rstd * gb.x, bfhi(w1[2]) * rstd * gb.y); o.w = pk2(bflo(w1[3]) * rstd * gb.z, bfhi(w1[3]) * rstd * gb.w);
            *(GAS v4u*)(cqn + (size_t)m * QL + 512 + 8 * lane) = o; } }
        { const unsigned w0[4] = {ckv0.x, ckv0.y, ckv0.z, ckv0.w}; float sq = 0.f;
#pragma unroll
          for (int jj = 0; jj < 4; ++jj) sq += bflo(w0[jj]) * bflo(w0[jj]) + bfhi(w0[jj]) * bfhi(w0[jj]);
          if (lane >= 32) sq = 0.f;
          const float rstd = 1.f / sqrtf(wave_sum(sq) * (1.f / KVL) + NORM_EPS);
          if (lane < 32) { const GAS f32x4* gp = (const GAS f32x4*)(gkv + 8 * lane); const f32x4 ga = gp[0], gb = gp[1]; v4u o;
            o.x = pk2(bflo(w0[0]) * rstd * ga.x, bfhi(w0[0]) * rstd * ga.y); o.y = pk2(bflo(w0[1]) * rstd * ga.z, bfhi(w0[1]) * rstd * ga.w);
            o.z = pk2(bflo(w0[2]) * rstd * gb.x, bfhi(w0[2]) * rstd * gb.y); o.w = pk2(bflo(w0[3]) * rstd * gb.z, bfhi(w0[3]) * rstd * gb.w);
            *(GAS v4u*)(ckvn + (size_t)m * KVL + 8 * lane) = o; } }
    }
}


__device__ __forceinline__ unsigned sortable(float f) { const unsigned u = __builtin_bit_cast(unsigned, f); return (u & 0x80000000u) ? ~u : (u | 0x80000000u); }
typedef short bf16x8 __attribute__((ext_vector_type(8)));
typedef short s16x4 __attribute__((ext_vector_type(4)));
typedef short v4i16_t __attribute__((ext_vector_type(4)));
typedef float f32x16 __attribute__((ext_vector_type(16)));
typedef float f32x2_t __attribute__((ext_vector_type(2))); typedef __bf16 bf16x2_t __attribute__((ext_vector_type(2)));
__device__ __forceinline__ unsigned cvtpk_s(float lo, float hi) { f32x2_t v = {lo, hi}; bf16x2_t b = __builtin_convertvector(v, bf16x2_t); return __builtin_bit_cast(unsigned, b); }
#define MFMA32(a, b, c) __builtin_amdgcn_mfma_f32_32x32x16_bf16((a), (b), (c), 0, 0, 0)
__device__ __forceinline__ int crow(int r, int hi) { return (r & 3) + 8 * (r >> 2) + 4 * hi; }
__device__ __forceinline__ s16x4 vtr(const LAS char* p) { return __builtin_bit_cast(s16x4, __builtin_amdgcn_ds_read_tr16_b64_v4i16((LAS v4i16_t*)p)); }
__device__ __forceinline__ bf16x8 pack8f(float a0, float a1, float a2, float a3, float a4, float a5, float a6, float a7) {
    v4u w; w.x = cvtpk_s(a0, a1); w.y = cvtpk_s(a2, a3); w.z = cvtpk_s(a4, a5); w.w = cvtpk_s(a6, a7); return __builtin_bit_cast(bf16x8, w);
}
constexpr int CW_QUEUE = 8192;
__device__ __forceinline__ unsigned* queue_word(unsigned char* ws, int layer, int k) { return (unsigned*)(ws + WS_CTL) + CW_QUEUE + (layer * 32 + k) * 64; }

template <int MODE> struct AttnCfg;
template <> struct AttnCfg<0> { static constexpr int NKS = 12, KROW = 384, KPW = 3; };
template <> struct AttnCfg<1> { static constexpr int NKS = 4, KROW = 128, KPW = 1; };
template <> struct AttnCfg<2> { static constexpr int NKS = 4, KROW = 128, KPW = 1; };
template <int MODE>
__device__ __forceinline__ void attn_unit(LAS unsigned char* lds, unsigned char* ws, int b, int h, int qb, int tid) {
    typedef AttnCfg<MODE> C;
    const int lane = tid & 63, wave = __builtin_amdgcn_readfirstlane(tid >> 6), r32 = lane & 31, hh = lane >> 5;
    const bf16* proj = (const bf16*)(ws + WS_PROJ); const bf16* qm = (const bf16*)(ws + WS_QMLA); const bf16* kvm = (const bf16*)(ws + WS_KVMLA); bf16* mix = (bf16*)(ws + WS_MIX);
    const int q0w = 256 * qb + 32 * wave, qabs = q0w + r32; const size_t mrow = (size_t)b * T + qabs;
    bf16x8 qf[C::NKS];
    if (MODE == 0) {
        const GAS v4u* qp = (const GAS v4u*)(qm + mrow * NUQ + h * 192);
        v4u raw[12];
#pragma unroll
        for (int ks = 0; ks < 12; ++ks) raw[ks] = qp[2 * ks + hh];
        unsigned char* wsl = ws; asm volatile("" : "+s"(wsl));
        const GAS f32x4* tp = (const GAS f32x4*)((const float2*)(wsl + WS_TABA) + qabs * 32);
#pragma unroll
        for (int ks = 8; ks < 10; ++ks) {
            unsigned x1w[4] = {raw[ks].x, raw[ks].y, raw[ks].z, raw[ks].w}, x2w[4] = {raw[ks + 2].x, raw[ks + 2].y, raw[ks + 2].z, raw[ks + 2].w};
            unsigned y1w[4], y2w[4];
#pragma unroll
            for (int jj = 0; jj < 4; ++jj) {
                const f32x4 cs = tp[(16 * (ks - 8) + 8 * hh) / 2 + jj];
                const float a1 = bflo(x1w[jj]), a2 = bflo(x2w[jj]), b1 = bfhi(x1w[jj]), b2 = bfhi(x2w[jj]);
                y1w[jj] = cvtpk_s(a1 * cs.x - a2 * cs.y, b1 * cs.z - b2 * cs.w);
                y2w[jj] = cvtpk_s(a2 * cs.x + a1 * cs.y, b2 * cs.z + b1 * cs.w);
            }
            raw[ks] = (v4u){y1w[0], y1w[1], y1w[2], y1w[3]}; raw[ks + 2] = (v4u){y2w[0], y2w[1], y2w[2], y2w[3]};
        }
#pragma unroll
        for (int ks = 0; ks < 12; ++ks) qf[ks] = __builtin_bit_cast(bf16x8, raw[ks]);
    } else if (MODE == 1) {
        const GAS v4u* qp = (const GAS v4u*)(proj + mrow * NIN + C_RQ + h * 64);
#pragma unroll
        for (int ks = 0; ks < C::NKS; ++ks) qf[ks] = __builtin_bit_cast(bf16x8, qp[2 * ks + hh]);
    } else {
        const int dsel = 32 * wave + r32;
#pragma unroll
        for (int ks = 0; ks < C::NKS; ++ks)
#pragma unroll
            for (int jj = 0; jj < 8; ++jj) qf[ks][jj] = (wave < 2 && 16 * ks + 8 * hh + jj == dsel) ? (short)0x3F80 : (short)0;
    }
    constexpr int KBYTES = 64 * C::KROW, BUFSZ = KBYTES + 16384;
    const size_t brow = (size_t)b * T;
    unsigned koffA[C::KPW]; bool kisA[C::KPW]; unsigned voffs[2];
#pragma unroll
    for (int i = 0; i < C::KPW; ++i) { const int o = (wave + 8 * i) * 1024 + lane * 16, row = o / C::KROW, pos = (o % C::KROW) / 16, c = (pos & ~7) | ((pos & 7) ^ ((row >> 1) & 7));
        if (MODE == 0) { kisA[i] = c < 16; koffA[i] = kisA[i] ? (unsigned)(row * 512 + c * 16) : (unsigned)(row * (NIN * 2) + (c - 16) * 16); }
        else { kisA[i] = true; koffA[i] = (unsigned)(row * (NIN * 2) + c * 16); } }
#pragma unroll
    for (int i = 0; i < 2; ++i) { const int row = 4 * (wave + 8 * i) + (lane >> 4), c = (lane & 15) ^ (4 * (row & 3)); voffs[i] = (unsigned)(row * (MODE == 0 ? 512 : NIN * 2) + c * 16); }
    const char* kbaseA = (MODE == 0) ? (const char*)(kvm + ((size_t)h * M + brow) * 256) : (const char*)(proj + brow * NIN + C_RK + h * 64);
    const char* kbaseB = (const char*)(proj + brow * NIN + C_KR);
    const char* vbase_ = (MODE == 0) ? (const char*)(kvm + ((size_t)h * M + brow) * 256 + 128) : (const char*)(proj + brow * NIN + C_RV + h * 128);
    auto issue = [&](int j, int boff) {
        const size_t stepA = (size_t)j * 64 * (MODE == 0 ? 512 : NIN * 2), stepB = (size_t)j * 64 * (NIN * 2);
#pragma unroll
        for (int i = 0; i < C::KPW; ++i) { const char* p = kisA[i] ? (kbaseA + stepA + koffA[i]) : (kbaseB + stepB + koffA[i]);
            __builtin_amdgcn_global_load_lds((const GAS unsigned*)p, (LAS unsigned*)(lds + boff + (wave + 8 * i) * 1024), 16, 0, 0); }
#pragma unroll
        for (int i = 0; i < 2; ++i) __builtin_amdgcn_global_load_lds((const GAS unsigned*)(vbase_ + stepA + voffs[i]), (LAS unsigned*)(lds + boff + KBYTES + (wave + 8 * i) * 1024), 16, 0, 0);
    };
    f32x16 o[4];
#pragma unroll
    for (int d = 0; d < 4; ++d)
#pragma unroll
        for (int i = 0; i < 16; ++i) o[d][i] = 0.f;
    float mrun = -1e30f, lrun = 0.f;
    constexpr float C2 = 0.07216878364870322f * 1.4426950408889634f;
    const float lg2 = (MODE != 0) ? log1pf(-exp2f(-5.f - (float)h)) * 1.4426950408889634f : 0.f;
    const int ntiles = 4 * (qb + 1), jlo = (MODE == 0) ? 0 : 4 * qb;
    const int trq = (lane & 15) >> 2, trp = lane & 3, trb = (lane >> 4) & 1;
    const int voff = (4 * hh + trq) * 256 + (2 * trb + (trp >> 1)) * 16 + (trp & 1) * 8;
    const int kt0 = hh ^ ((r32 >> 1) & 7);
    constexpr int ST_OFF = 3 * BUFSZ;
    if (MODE == 1 && qb > 0) {
        const int sd = tid >> 3, se = (tid & 7) * 16; float sa[16];
#pragma unroll
        for (int i = 0; i < 16; ++i) sa[i] = 0.f;
        const float* bu = (const float*)(ws + WS_BU) + ((size_t)((b * 8 + h) * 16) * 64 + sd) * 128 + se;
#pragma unroll 4
        for (int up = 0; up < qb; ++up) { const float wgt = __builtin_amdgcn_exp2f((float)(256 * (qb - 1 - up)) * lg2); const GAS f32x4* p4 = (const GAS f32x4*)(bu + (size_t)up * 64 * 128);
#pragma unroll
            for (int i = 0; i < 4; ++i) { const f32x4 v = p4[i]; sa[4 * i] = fmaf(wgt, v.x, sa[4 * i]); sa[4 * i + 1] = fmaf(wgt, v.y, sa[4 * i + 1]); sa[4 * i + 2] = fmaf(wgt, v.z, sa[4 * i + 2]); sa[4 * i + 3] = fmaf(wgt, v.w, sa[4 * i + 3]); } }
        LAS unsigned char* st = lds + ST_OFF + sd * 256; const int c0 = (tid & 7) * 2, sw = 4 * (sd & 3);
        *(LAS v4u*)(st + ((c0 ^ sw) << 4)) = (v4u){cvtpk_s(sa[0], sa[1]), cvtpk_s(sa[2], sa[3]), cvtpk_s(sa[4], sa[5]), cvtpk_s(sa[6], sa[7])};
        *(LAS v4u*)(st + (((c0 + 1) ^ sw) << 4)) = (v4u){cvtpk_s(sa[8], sa[9]), cvtpk_s(sa[10], sa[11]), cvtpk_s(sa[12], sa[13]), cvtpk_s(sa[14], sa[15])};
    }
    int b_cur = 0, b_nxt = BUFSZ, b_nn = 2 * BUFSZ;
    issue(jlo, b_cur); if (jlo + 1 < ntiles) issue(jlo + 1, b_nxt);
    constexpr int PW = C::KPW + 2;
    for (int j = jlo; j < ntiles; ++j) {
        if (j + 1 < ntiles) { if (PW == 5) asm volatile("s_waitcnt vmcnt(5) lgkmcnt(0)\n\ts_barrier" ::: "memory"); else asm volatile("s_waitcnt vmcnt(3) lgkmcnt(0)\n\ts_barrier" ::: "memory"); }
        else asm volatile("s_waitcnt vmcnt(0) lgkmcnt(0)\n\ts_barrier" ::: "memory");
        if (j + 2 < ntiles) issue(j + 2, b_nn);
        if ((MODE == 2) ? (wave < 2) : (64 * j <= q0w + 31)) {
            const LAS unsigned char* kb = lds + b_cur + r32 * C::KROW;
            const LAS unsigned char* vb = lds + b_cur + KBYTES + voff;
            f32x16 s0, s1;
#pragma unroll
            for (int i = 0; i < 16; ++i) { s0[i] = 0.f; s1[i] = 0.f; }
            { bf16x8 kfa[3], kfb[3];
#define AT_KREAD(ks_, sl_) do { const int kco_ = (((2 * (ks_)) & ~7) << 4) | ((((2 * (ks_)) & 7) ^ kt0) << 4); kfa[sl_] = *(const LAS bf16x8*)(kb + kco_); kfb[sl_] = *(const LAS bf16x8*)(kb + 32 * C::KROW + kco_); } while (0)
              AT_KREAD(0, 0); AT_KREAD(1, 1);
              __builtin_amdgcn_sched_barrier(0);
#pragma unroll
              for (int ks = 0; ks < C::NKS; ++ks) {
                  if (ks + 2 < C::NKS) AT_KREAD(ks + 2, (ks + 2) % 3);
                  s0 = MFMA32(kfa[ks % 3], qf[ks], s0); s1 = MFMA32(kfb[ks % 3], qf[ks], s1);
                  __builtin_amdgcn_sched_barrier(0);
              }
#undef AT_KREAD
            }
            const int dq = qabs - 64 * j - 4 * hh;
            bf16x8 pf[4];
            if (MODE == 0) {
                if (64 * j + 63 > q0w) {
#pragma unroll
                    for (int i = 0; i < 16; ++i) { const int c = (i & 3) + 8 * (i >> 2); if (c > dq) s0[i] = -__builtin_inff(); if (c + 32 > dq) s1[i] = -__builtin_inff(); }
                }
                float tmax = s0[0];
#pragma unroll
                for (int i = 1; i < 16; ++i) tmax = fmaxf(tmax, s0[i]);
#pragma unroll
                for (int i = 0; i < 16; ++i) tmax = fmaxf(tmax, s1[i]);
                tmax = fmaxf(tmax, __shfl_xor(tmax, 32));
                const float mnew = fmaxf(mrun, tmax); const float alpha = __builtin_amdgcn_exp2f((mrun - mnew) * C2); const bool grew = __builtin_amdgcn_ballot_w64(mnew > mrun) != 0ull; mrun = mnew;
                const float mc = -mnew * C2; float ps = 0.f;
#pragma unroll
                for (int i = 0; i < 16; ++i) { s0[i] = __builtin_amdgcn_exp2f(fmaf(s0[i], C2, mc)); s1[i] = __builtin_amdgcn_exp2f(fmaf(s1[i], C2, mc)); ps += s0[i] + s1[i]; }
                lrun = lrun * alpha + ps;
                if (grew) {
#pragma unroll
                for (int d = 0; d < 4; ++d)
#pragma unroll
                    for (int i = 0; i < 16; ++i) o[d][i] *= alpha; }
            } else {
                const int dqq = (MODE == 2) ? (256 * qb + 255 - 64 * j - 4 * hh) : dq;
#pragma unroll
                for (int i = 0; i < 16; ++i) { const int c = (i & 3) + 8 * (i >> 2);
                    const float w0 = (c <= dqq) ? __builtin_amdgcn_exp2f((float)(dqq - c) * lg2) : 0.f, w1 = (c + 32 <= dqq) ? __builtin_amdgcn_exp2f((float)(dqq - c - 32) * lg2) : 0.f;
                    s0[i] *= w0; s1[i] *= w1; }
            }
            pf[0] = pack8f(s0[0], s0[1], s0[2], s0[3], s0[4], s0[5], s0[6], s0[7]); pf[1] = pack8f(s0[8], s0[9], s0[10], s0[11], s0[12], s0[13], s0[14], s0[15]);
            pf[2] = pack8f(s1[0], s1[1], s1[2], s1[3], s1[4], s1[5], s1[6], s1[7]); pf[3] = pack8f(s1[8], s1[9], s1[10], s1[11], s1[12], s1[13], s1[14], s1[15]);
            { bf16x8 vfr[3];
#define AT_VREAD(ix_, sl_) do { const int s_ = (ix_) >> 2, d_ = (ix_) & 3; const s16x4 lo_ = vtr((const LAS char*)(vb + (16 * s_) * 256 + ((d_ ^ trq) << 6))), hi_ = vtr((const LAS char*)(vb + (16 * s_ + 8) * 256 + ((d_ ^ trq) << 6))); \
                                vfr[sl_] = __builtin_shufflevector(lo_, hi_, 0, 1, 2, 3, 4, 5, 6, 7); } while (0)
              AT_VREAD(0, 0); AT_VREAD(1, 1);
              __builtin_amdgcn_sched_barrier(0);
#pragma unroll
              for (int ix = 0; ix < 16; ++ix) {
                  if (ix + 2 < 16) AT_VREAD(ix + 2, (ix + 2) % 3);
                  o[ix & 3] = MFMA32(vfr[ix % 3], pf[ix >> 2], o[ix & 3]);
                  __builtin_amdgcn_sched_barrier(0);
              }
#undef AT_VREAD
            }
        }
        { const int t_ = b_cur; b_cur = b_nxt; b_nxt = b_nn; b_nn = t_; }
    }
    if (MODE == 1 && qb > 0) {
        const float dqv = __builtin_amdgcn_exp2f((float)(qabs - 256 * qb + 1) * lg2);
        const bf16* qrow = proj + mrow * NIN + C_RQ + h * 64 + 4 * hh;
        const LAS unsigned char* sb = lds + ST_OFF + voff;
#pragma unroll
        for (int s = 0; s < 4; ++s) {
            const v2u qlo = *(const GAS v2u*)(qrow + 16 * s), qhi = *(const GAS v2u*)(qrow + 16 * s + 8);
            const bf16x8 pq = pack8f(bflo(qlo.x) * dqv, bfhi(qlo.x) * dqv, bflo(qlo.y) * dqv, bfhi(qlo.y) * dqv, bflo(qhi.x) * dqv, bfhi(qhi.x) * dqv, bflo(qhi.y) * dqv, bfhi(qhi.y) * dqv);
#pragma unroll
            for (int d = 0; d < 4; ++d) {
                const s16x4 lo = vtr((const LAS char*)(sb + (16 * s) * 256 + ((d ^ trq) << 6))), hi = vtr((const LAS char*)(sb + (16 * s + 8) * 256 + ((d ^ trq) << 6)));
                const bf16x8 vf = __builtin_shufflevector(lo, hi, 0, 1, 2, 3, 4, 5, 6, 7);
                o[d] = MFMA32(vf, pq, o[d]);
            }
        }
    }
    if (MODE == 2) {
        if (wave < 2) { float* bo = (float*)(ws + WS_BU) + ((size_t)(((b * 8 + h) * 16 + qb) * 64 + 32 * wave + r32)) * 128 + 4 * hh;
#pragma unroll
            for (int d = 0; d < 4; ++d)
#pragma unroll
                for (int g = 0; g < 4; ++g) *(GAS f32x4*)(bo + 32 * d + 8 * g) = (f32x4){o[d][4 * g], o[d][4 * g + 1], o[d][4 * g + 2], o[d][4 * g + 3]}; }
        return;
    }
    if (MODE == 0) {
        const float lt = lrun + __shfl_xor(lrun, 32); const float il = 1.f / lt;
        bf16* orow = mix + mrow * MIXW + MIX_MLA + h * 128 + 4 * hh;
#pragma unroll
        for (int d = 0; d < 4; ++d)
#pragma unroll
            for (int g = 0; g < 4; ++g) { v2u w; w.x = cvtpk_s(o[d][4 * g] * il, o[d][4 * g + 1] * il); w.y = cvtpk_s(o[d][4 * g + 2] * il, o[d][4 * g + 3] * il);
                *(GAS v2u*)(orow + 32 * d + 8 * g) = w; }
    } else {
        float ss = 0.f;
#pragma unroll
        for (int d = 0; d < 4; ++d)
#pragma unroll
            for (int i = 0; i < 16; ++i) ss += o[d][i] * o[d][i];
        ss += __shfl_xor(ss, 32);
        const float rstd = 1.f / sqrtf(ss * (1.f / 128.f) + NORM_EPS);
        const bf16* grow = proj + mrow * NIN + C_RG + h * 128 + 4 * hh; bf16* orow = mix + mrow * MIXW + MIX_RET + h * 128 + 4 * hh;
#pragma unroll
        for (int d = 0; d < 4; ++d)
#pragma unroll
            for (int g = 0; g < 4; ++g) { const v2u gw = *(const GAS v2u*)(grow + 32 * d + 8 * g);
                const float g0 = bflo(gw.x), g1 = bfhi(gw.x), g2 = bflo(gw.y), g3 = bfhi(gw.y);
                const float y0 = (g0 / (1.f + __expf(-g0))) * (o[d][4 * g] * rstd), y1 = (g1 / (1.f + __expf(-g1))) * (o[d][4 * g + 1] * rstd);
                const float y2 = (g2 / (1.f + __expf(-g2))) * (o[d][4 * g + 2] * rstd), y3 = (g3 / (1.f + __expf(-g3))) * (o[d][4 * g + 3] * rstd);
                v2u w; w.x = cvtpk_s(y0, y1); w.y = cvtpk_s(y2, y3); *(GAS v2u*)(orow + 32 * d + 8 * g) = w; }
    }
}
template <int MODE> __device__ __forceinline__ void attn_phase(LAS unsigned char* lds, const int wave_s, int layer, int qk = 0) {
    constexpr int NH = (MODE == 0) ? 12 : 8, NU = BATCH * NH * 16;
    unsigned char* ws = KA_WS(); const int tid = tid_now(wave_s);
    unsigned* ctr = queue_word(ws, layer, MODE + qk);
    volatile LAS unsigned* uw = (volatile LAS unsigned*)(lds + LDSCTL_OFF);
    for (;;) {
        __syncthreads();
        if (tid == 0) uw[0] = __hip_atomic_fetch_add(ctr, 1u, __ATOMIC_RELAXED, __HIP_MEMORY_SCOPE_AGENT);
        __syncthreads();
        const unsigned u = uw[0];
        if (u >= (unsigned)NU) break;
        const int qb = 15 - (int)(u / (BATCH * NH)), bh = (int)(u % (BATCH * NH));
        attn_unit<MODE>(lds, ws, bh / NH, bh % NH, qb, tid);
    }
}

__device__ __forceinline__ float relu_i(float x) { const int i = __builtin_bit_cast(int, x); return __builtin_bit_cast(float, i > 0 ? i : 0); }
__device__ __forceinline__ void indexer_mfma(LAS unsigned char* lds, const int wave_s) {
    Frame F = make_frame(lds, wave_s);
    const bf16* proj = (const bf16*)(F.ws + WS_PROJ); int* sel = (int*)(F.ws + WS_SEL); float* isc = (float*)(F.ws + WS_ISC);
    const int lane = F.lane, r32 = lane & 31, hh = lane >> 5;
    for (int vw = blockIdx.x; vw < 256; vw += NWG)
    for (int it = 0; it < 2; ++it) {
        const int b = vw >> 7; const int jq = it ? (255 - (vw & 127)) : (vw & 127); const int t0 = 16 * jq, tA = t0 + 2 * F.wave; const size_t mA = (size_t)b * T + tA;
        if (t0 + 15 < TOPK) {
            for (int j = lane; j <= tA; j += 64) sel[mA * TOPK + j] = j;
            for (int j = lane; j <= tA + 1; j += 64) sel[(mA + 1) * TOPK + j] = j;
            continue; }
        bf16x8 afA[8], afB[8];
        { const GAS v4u* qp = (const GAS v4u*)(proj + mA * NIN + C_IQ + r32 * 128); const GAS v4u* qp2 = (const GAS v4u*)(proj + (mA + 1) * NIN + C_IQ + r32 * 128);
#pragma unroll
          for (int ks = 0; ks < 8; ++ks) { afA[ks] = __builtin_bit_cast(bf16x8, qp[2 * ks + hh]); afB[ks] = __builtin_bit_cast(bf16x8, qp2[2 * ks + hh]); } }
        float wvA[16], wvB[16];
#pragma unroll
        for (int r = 0; r < 16; ++r) { wvA[r] = bf2f(proj[mA * NIN + C_IW + crow(r, hh)]) * (0.17677669529663687f * 0.08838834764831845f);
                                       wvB[r] = bf2f(proj[(mA + 1) * NIN + C_IW + crow(r, hh)]) * (0.17677669529663687f * 0.08838834764831845f); }
        float* srowA = isc + mA * T; float* srowB = srowA + T;
        const int nch = (t0 + 15) / 256 + 1;
        const char* ikb = (const char*)(F.ws + WS_IKC) + (size_t)b * T * 256;
        const unsigned lane_off = (unsigned)((lane >> 4) * 256 + (((lane & 15) ^ ((4 * (F.wave & 3) + (lane >> 4)) & 15)) << 4));
        auto issue = [&](int c, int i0, int n) {
            LAS unsigned char* dst = F.lds + (c & 1) * 65536; int cc = c; asm volatile("" : "+s"(cc)); unsigned lo_ = lane_off; asm volatile("" : "+v"(lo_));
            for (int i = i0; i < i0 + n; ++i) { const int pi = F.wave + 8 * i; const unsigned off = lo_ + (unsigned)((cc * 256 + 4 * pi) * 256);
                __builtin_amdgcn_global_load_lds((const GAS unsigned*)(ikb + off), (LAS unsigned*)(dst + pi * 1024), 16, 0, 0); }
        };
        __syncthreads();
        issue(0, 0, 8);
        f32x16 a0, b0, a1, b1;
#pragma unroll
        for (int i = 0; i < 16; ++i) { a1[i] = 0.f; b1[i] = 0.f; }
        float xa0 = 0.f, xb0 = 0.f; int sprev = -1;
        for (int c = 0; c < nch; ++c) {
            if (c == 0) VM_WAIT(); else asm volatile("s_waitcnt vmcnt(4)" ::: "memory");
            __syncthreads();
            const bool more = c + 1 < nch;
            const LAS unsigned char* kb = F.lds + (c & 1) * 65536 + r32 * 256;
#pragma unroll 1
            for (int pp = 0; pp < 4; ++pp) {
                const int s0 = c * 256 + pp * 64; if (s0 > tA + 1) break;
                int ll = lane & 15; asm volatile("" : "+v"(ll));
                const LAS unsigned char* kbp = kb + (pp * 64) * 256;
                if (more && pp < 2) issue(c + 1, pp * 4, 2);
                __builtin_amdgcn_sched_barrier(0);
#pragma unroll
                for (int i = 0; i < 16; ++i) { a0[i] = 0.f; b0[i] = 0.f; }
                float xa1 = 0.f, xb1 = 0.f;
#pragma unroll
                for (int ks = 0; ks < 8; ++ks) { const bf16x8 bk = *(const LAS bf16x8*)(kbp + (((2 * ks + hh) ^ ll) << 4)); a0 = MFMA32(afA[ks], bk, a0); b0 = MFMA32(afB[ks], bk, b0); }
#pragma unroll
                for (int r = 0; r < 16; ++r) { xa1 = fmaf(wvA[r], relu_i(a1[r]), xa1); xb1 = fmaf(wvB[r], relu_i(b1[r]), xb1); }
#pragma unroll
                for (int i = 0; i < 16; ++i) { __builtin_amdgcn_sched_group_barrier(0x008, 1, 0); __builtin_amdgcn_sched_group_barrier(0x002, 4, 0); }
                __builtin_amdgcn_sched_barrier(0);
                asm volatile("" : "+v"(xa1), "+v"(xb1));
                if (sprev >= 0) {
                    const float ta0 = xa0 + __shfl_xor(xa0, 32), ta1 = xa1 + __shfl_xor(xa1, 32), tb0 = xb0 + __shfl_xor(xb0, 32), tb1 = xb1 + __shfl_xor(xb1, 32);
                    srowA[sprev + lane] = hh ? ta1 : ta0;
                    srowB[sprev + lane] = hh ? tb1 : tb0; }
                if (more && pp < 2) issue(c + 1, pp * 4 + 2, 2);
                __builtin_amdgcn_sched_barrier(0);
#pragma unroll
                for (int i = 0; i < 16; ++i) { a1[i] = 0.f; b1[i] = 0.f; }
                xa0 = 0.f; xb0 = 0.f;
#pragma unroll
                for (int ks = 0; ks < 8; ++ks) { const bf16x8 bk = *(const LAS bf16x8*)(kbp + 32 * 256 + (((2 * ks + hh) ^ ll) << 4)); a1 = MFMA32(afA[ks], bk, a1); b1 = MFMA32(afB[ks], bk, b1); }
#pragma unroll
                for (int r = 0; r < 16; ++r) { xa0 = fmaf(wvA[r], relu_i(a0[r]), xa0); xb0 = fmaf(wvB[r], relu_i(b0[r]), xb0); }
#pragma unroll
                for (int i = 0; i < 16; ++i) { __builtin_amdgcn_sched_group_barrier(0x008, 1, 0); __builtin_amdgcn_sched_group_barrier(0x002, 4, 0); }
                __builtin_amdgcn_sched_barrier(0);
                sprev = s0;
            }
        }
        { float xa1 = 0.f, xb1 = 0.f;
#pragma unroll
          for (int r = 0; r < 16; ++r) { xa1 = fmaf(wvA[r], relu_i(a1[r]), xa1); xb1 = fmaf(wvB[r], relu_i(b1[r]), xb1); }
          const float ta0 = xa0 + __shfl_xor(xa0, 32), ta1 = xa1 + __shfl_xor(xa1, 32), tb0 = xb0 + __shfl_xor(xb0, 32), tb1 = xb1 + __shfl_xor(xb1, 32);
          srowA[sprev + lane] = hh ? ta1 : ta0;
          srowB[sprev + lane] = hh ? tb1 : tb0; }
        VM_WAIT(); asm volatile("" ::: "memory");
        int lane2 = lane; asm volatile("" : "+v"(lane2));
#pragma unroll 1
        for (int qq = 0; qq < 2; ++qq) {
            const int t = tA + qq; const size_t m = mA + qq;
            unsigned u[64]; float s1 = 0.f, s2 = 0.f;
            { const float* sp = (qq ? srowB : srowA) + lane2;
#pragma unroll
              for (int g = 0; g < 64; ++g) { const float v = sp[g * 64]; const bool ok = (g * 64 + lane2 <= t); u[g] = ok ? sortable(v) : 0u;
                                             if ((g & 3) == 0) { const float vm = ok ? v : 0.f; s1 += vm; s2 = fmaf(vm, vm, s2); } } }
            s1 = wave_sum(s1); s2 = wave_sum(s2);
            float candf, dens;
            { const int nf = (t + 1 - 64) / 256 + 1, nfc = nf > 16 ? 16 : nf; int part = t + 1 - 256 * nfc; part = part < 0 ? 0 : (part > 64 ? 64 : part); const float ns = (float)(64 * nfc + (nfc < 16 ? part : 0));
              const float mu = s1 / ns, var = fmaxf(s2 / ns - mu * mu, 1e-30f), sd = sqrtf(var);
              const float n = (float)(t + 1), p = (float)TOPK / n, pm = fminf(p, 1.f - p);
              const float tt = sqrtf(-2.f * __logf(pm)); float z = tt - (2.30753f + 0.27061f * tt) / (1.f + tt * (0.99229f + 0.04481f * tt)); if (p > 0.5f) z = -z;
              dens = fmaxf(n * 0.3989423f * __expf(-0.5f * z * z) / sd, 1e-20f); candf = mu + z * sd; }
            unsigned lo_u = 1u, hi_u = 0xFFFFFFFFu, thr = 1u, cl = 0u; float lo_f = 0.f, hi_f = 0.f; int cnt_lo = 0, cnt_hi = 0; bool lo_ok = false, hi_ok = false, exact = false;
            for (int it = 0; ; ++it) {
                if (hi_u - lo_u <= 1u) { thr = lo_u; break; }
                unsigned cu = sortable(candf);
                if (it >= 12 || !(cu > lo_u && cu < hi_u)) cu = lo_u + ((hi_u - lo_u) >> 1);
                cl = 0u;
#pragma unroll
                for (int g = 0; g < 64; ++g) cl += (u[g] >= cu) ? 1u : 0u;
                int cnt = 0;
#pragma unroll
                for (int k = 0; k < 7; ++k) cnt += __popcll(__ballot((cl >> k) & 1u)) << k;
                if (cnt == TOPK) { thr = cu; exact = true; break; }
                const float cf = __builtin_bit_cast(float, (cu & 0x80000000u) ? (cu & 0x7fffffffu) : ~cu);
                if (cnt > TOPK) { lo_u = cu; lo_f = cf; cnt_lo = cnt; lo_ok = true; } else { hi_u = cu; hi_f = cf; cnt_hi = cnt; hi_ok = true; }
                if (lo_ok && hi_ok) candf = lo_f + (hi_f - lo_f) * (((float)cnt_lo - 255.5f) / (float)(cnt_lo - cnt_hi));
                else { candf = cf + ((float)cnt - 255.5f) / dens; dens *= 0.5f; }
            }
            if (exact) {
                int pre = 0; const unsigned long long ltm = (1ull << lane2) - 1ull;
#pragma unroll
                for (int k = 0; k < 7; ++k) pre += __popcll(__ballot((cl >> k) & 1u) & ltm) << k;
                int* sp2 = sel + m * TOPK + pre;
#pragma unroll
                for (int g = 0; g < 64; ++g) { if (u[g] >= thr) { *sp2 = g * 64 + lane2; ++sp2; } }
            } else {
            int cgt = 0;
            { unsigned cl2 = 0u;
#pragma unroll
              for (int g = 0; g < 64; ++g) cl2 += (u[g] > thr) ? 1u : 0u;
#pragma unroll
              for (int k = 0; k < 7; ++k) cgt += __popcll(__ballot((cl2 >> k) & 1u)) << k; }
            const int need_eq = TOPK - cgt; int base = 0, eq_seen = 0;
            const unsigned long long ltmask = (1ull << lane2) - 1ull;
#pragma unroll
            for (int g = 0; g < 64; ++g) {
                const bool gt = u[g] > thr, eq = u[g] == thr;
                const unsigned long long meq = __ballot(eq);
                const bool take = gt || (eq && (eq_seen + __popcll(meq & ltmask)) < need_eq);
                const unsigned long long ms = __ballot(take);
                if (take) sel[m * TOPK + base + __popcll(ms & ltmask)] = g * 64 + lane2;
                base += __popcll(ms); eq_seen += __popcll(meq);
            }
            }
            asm volatile("" ::: "memory");
        }
    }
}

#define MFMA16(a, b, c) __builtin_amdgcn_mfma_f32_16x16x32_bf16((a), (b), (c), 0, 0, 0)
#define SCHED_FENCE() __builtin_amdgcn_sched_barrier(0)
__device__ __forceinline__ void dsa_fast(LAS unsigned char* lds, const int wave_s, int layer, int qk = 0) {
    Frame F = make_frame(lds, wave_s);
    const bf16* proj = (const bf16*)(F.ws + WS_PROJ); const int* sel = (const int*)(F.ws + WS_SEL); bf16* mix = (bf16*)(F.ws + WS_MIX);
    LAS unsigned char* vring = F.lds + RING_OFF + F.wave * 16384;
    LAS unsigned char* xtra = F.lds + XTRA_OFF + F.wave * XTRA_WAVE;
    LAS unsigned short* il = (LAS unsigned short*)xtra;
    LAS float* sl = (LAS float*)(xtra + 512);
    volatile LAS unsigned* uw = (volatile LAS unsigned*)(F.lds + LDSCTL_OFF);
    const int lane = F.lane, c16 = lane & 15, kq = lane >> 4; const int tid = F.wave * 64 + lane;
    constexpr float C2 = 0.08838834764831845f * 1.4426950408889634f;
    const unsigned koff = (unsigned)(((lane & 15) ^ (lane >> 4)) << 4);
    const unsigned voff0 = (unsigned)(((lane & 15) ^ (2 * (lane >> 4))) << 4), voff1 = voff0 ^ 128u;
    const int trq = (lane & 15) >> 2, trp = lane & 3;
    int combo = (int)(xb_xcc_id() & 7u), tries = 0;
    bf16x8 ones;
#pragma unroll
    for (int j = 0; j < 8; ++j) ones[j] = (short)0x3F80;
    unsigned pend = 0u;
    if (tid == 0) pend = __hip_atomic_fetch_add(queue_word(F.ws, layer, 8 + combo + qk), 1u, __ATOMIC_RELAXED, __HIP_MEMORY_SCOPE_AGENT);
    for (int itn = 0;; ++itn) {
        if (tid == 0) {
            unsigned u = 0xffffffffu, v = pend;
            for (;;) { if (v < 512u) { u = (unsigned)combo * 512u + v; break; } combo = (combo + 1) & 7; if (++tries >= 8) break;
                v = __hip_atomic_fetch_add(queue_word(F.ws, layer, 8 + combo + qk), 1u, __ATOMIC_RELAXED, __HIP_MEMORY_SCOPE_AGENT); }
            uw[itn & 1] = u;
            if (u != 0xffffffffu) pend = __hip_atomic_fetch_add(queue_word(F.ws, layer, 8 + combo + qk), 1u, __ATOMIC_RELAXED, __HIP_MEMORY_SCOPE_AGENT);
        }
        __syncthreads();
        const unsigned u = uw[itn & 1];
        if (u == 0xffffffffu) break;
        const int cb = (int)(u >> 9), b = cb >> 2, n = cb & 3, t = (int)(u & 511u) * 8 + F.wave; const size_t m = (size_t)b * T + t; const int nsel = (t + 1 < TOPK) ? t + 1 : TOPK;
        { int sv[4];
#pragma unroll
          for (int i = 0; i < 4; ++i) sv[i] = sel[m * TOPK + lane + 64 * i];
#pragma unroll
          for (int i = 0; i < 4; ++i) { const int j = lane + 64 * i; il[j] = (unsigned short)((j < nsel && (unsigned)sv[i] < (unsigned)T) ? sv[i] : 0); } }
        bf16x8 qf[4];
        { const GAS v4u* qp = (const GAS v4u*)(proj + m * NIN + C_DQ + (n * 3 + (c16 < 3 ? c16 : 0)) * 128);
          v4u w[4];
#pragma unroll
          for (int ks = 0; ks < 4; ++ks) w[ks] = qp[ks * 4 + kq];
#pragma unroll
          for (int ks = 0; ks < 4; ++ks) { if (c16 >= 3) w[ks] = (v4u){0u, 0u, 0u, 0u}; qf[ks] = __builtin_bit_cast(bf16x8, w[ks]); } }
        LDS_WAIT(); asm volatile("" ::: "memory");
        const char* kslab = (const char*)((const bf16*)(F.ws + WS_DKC) + ((size_t)(b * 4 + n)) * T * 128);
        const char* vslab = (const char*)((const bf16*)(F.ws + WS_DVC) + ((size_t)(b * 4 + n)) * T * 128);
        f32x4 sc[16];
#define DSA_KDMA(kr) do { LAS unsigned char* dst = vring + ((kr) & 1) * 8192; _Pragma("unroll") for (int i = 0; i < 8; ++i) { \
            const unsigned idx = il[32 * (kr) + 4 * i + (lane >> 4)]; const unsigned off = idx * 256u + (koff ^ (unsigned)((i & 3) << 6)); \
            __builtin_amdgcn_global_load_lds((const GAS unsigned*)(kslab + off), (LAS unsigned*)(dst + i * 1024), 16, 0, 0); } } while (0)
#define DSA_VDMA(kb) do { LAS unsigned char* dst = vring + ((kb) & 1) * 8192; _Pragma("unroll") for (int i = 0; i < 8; ++i) { \
            const unsigned idx = il[32 * (kb) + 4 * i + (lane >> 4)]; const unsigned off = idx * 256u + (((i >> 1) & 1) ? voff1 : voff0); \
            __builtin_amdgcn_global_load_lds((const GAS unsigned*)(vslab + off), (LAS unsigned*)(dst + i * 1024), 16, 0, 0); } } while (0)
#define DSA_KDMA1(kr, i) do { const unsigned idx = il[32 * (kr) + 4 * (i) + (lane >> 4)]; const unsigned off = idx * 256u + (koff ^ (unsigned)(((i) & 3) << 6)); \
            __builtin_amdgcn_global_load_lds((const GAS unsigned*)(kslab + off), (LAS unsigned*)(vring + ((kr) & 1) * 8192 + (i) * 1024), 16, 0, 0); } while (0)
#define DSA_VDMA1(kb, i) do { const unsigned idx = il[32 * (kb) + 4 * (i) + (lane >> 4)]; const unsigned off = idx * 256u + ((((i) >> 1) & 1) ? voff1 : voff0); \
            __builtin_amdgcn_global_load_lds((const GAS unsigned*)(vslab + off), (LAS unsigned*)(vring + ((kb) & 1) * 8192 + (i) * 1024), 16, 0, 0); } while (0)
        DSA_KDMA(0); DSA_KDMA(1);
#pragma unroll
        for (int kr = 0; kr < 8; ++kr) {
            asm volatile("s_waitcnt vmcnt(8)" ::: "memory");
            const LAS unsigned char* ks_ = vring + (kr & 1) * 8192 + c16 * 256;
            bf16x8 af_[2][4];
#pragma unroll
            for (int bi = 0; bi < 2; ++bi)
#pragma unroll
                for (int ks = 0; ks < 4; ++ks) af_[bi][ks] = *(const LAS bf16x8*)(ks_ + bi * 4096 + (((ks * 4 + kq) ^ c16) << 4));
            LDS_WAIT(); asm volatile("" ::: "memory");
            f32x4 acc0 = (f32x4){0.f, 0.f, 0.f, 0.f}, acc1 = (f32x4){0.f, 0.f, 0.f, 0.f};
#pragma unroll
            for (int p = 0; p < 8; ++p) {
                if (p < 4) acc0 = MFMA16(af_[0][p & 3], qf[p & 3], acc0); else acc1 = MFMA16(af_[1][p & 3], qf[p & 3], acc1);
                SCHED_FENCE();
                if (kr + 2 < 8) { DSA_KDMA1(kr + 2, p); } else { DSA_VDMA1(kr - 6, p); }
                SCHED_FENCE();
            }
            sc[2 * kr] = acc0; sc[2 * kr + 1] = acc1;
        }
        if (nsel < TOPK) {
#pragma unroll
            for (int blk = 0; blk < 16; ++blk)
#pragma unroll
                for (int i = 0; i < 4; ++i) { const int j = blk * 16 + 4 * kq + i; if (j >= nsel) sc[blk][i] = -__builtin_inff(); }
        }
        float mx = sc[0][0];
#pragma unroll
        for (int blk = 0; blk < 16; ++blk)
#pragma unroll
            for (int i = 0; i < 4; ++i) mx = fmaxf(mx, sc[blk][i]);
        mx = fmaxf(mx, __shfl_xor(mx, 16)); mx = fmaxf(mx, __shfl_xor(mx, 32));
        if (c16 < 3) {
#pragma unroll
            for (int blk = 0; blk < 16; ++blk) *(LAS f32x4*)(sl + c16 * 256 + blk * 16 + 4 * kq) = sc[blk];
        }
        const float m0 = -rdlane(mx, 0) * C2, m1 = -rdlane(mx, 1) * C2, m2 = -rdlane(mx, 2) * C2;
        LDS_WAIT(); asm volatile("" ::: "memory");
        { const f32x4 s0 = *(const LAS f32x4*)(sl + 4 * lane), s1 = *(const LAS f32x4*)(sl + 256 + 4 * lane), s2 = *(const LAS f32x4*)(sl + 512 + 4 * lane);
          float p0[4], p1[4], p2[4];
#pragma unroll
          for (int e = 0; e < 4; ++e) { p0[e] = __builtin_amdgcn_exp2f(fmaf(s0[e], C2, m0)); p1[e] = __builtin_amdgcn_exp2f(fmaf(s1[e], C2, m1)); p2[e] = __builtin_amdgcn_exp2f(fmaf(s2[e], C2, m2)); }
          LDS_WAIT(); asm volatile("" ::: "memory");
          LAS unsigned char* pb = (LAS unsigned char*)sl;
          *(LAS v2u*)(pb + 8 * lane) = (v2u){cvtpk_s(p0[0], p0[1]), cvtpk_s(p0[2], p0[3])};
          *(LAS v2u*)(pb + 512 + 8 * lane) = (v2u){cvtpk_s(p1[0], p1[1]), cvtpk_s(p1[2], p1[3])};
          *(LAS v2u*)(pb + 1024 + 8 * lane) = (v2u){cvtpk_s(p2[0], p2[1]), cvtpk_s(p2[2], p2[3])}; }
        LDS_WAIT(); asm volatile("" ::: "memory");
        f32x4 oacc[8], lacc = (f32x4){0.f, 0.f, 0.f, 0.f};
#pragma unroll
        for (int d = 0; d < 8; ++d) oacc[d] = (f32x4){0.f, 0.f, 0.f, 0.f};
        const LAS unsigned char* pbr = (const LAS unsigned char*)sl + (c16 < 3 ? c16 : 0) * 512 + kq * 16;
        const int trrow = (8 * kq + trq) * 256; const int trsw = 2 * trq + 8 * (kq & 1);
#pragma unroll 1
        for (int kb = 0; kb < 8; ++kb) {
            if (kb < 7) asm volatile("s_waitcnt vmcnt(8)" ::: "memory"); else asm volatile("s_waitcnt vmcnt(0)" ::: "memory");
            const LAS unsigned char* vs = vring + (kb & 1) * 8192 + trrow + (trp & 1) * 8;
            v4u pw = *(const LAS v4u*)(pbr + kb * 64); if (c16 >= 3) pw = (v4u){0u, 0u, 0u, 0u};
            const bf16x8 pf = __builtin_bit_cast(bf16x8, pw);
            bf16x8 vf_[8];
#pragma unroll
            for (int d = 0; d < 8; ++d) { const int cpos = ((2 * d + (trp >> 1)) ^ trsw) << 4;
                const s16x4 lo = vtr((const LAS char*)(vs + cpos)), hi = vtr((const LAS char*)(vs + 4 * 256 + cpos));
                vf_[d] = __builtin_shufflevector(lo, hi, 0, 1, 2, 3, 4, 5, 6, 7); }
            LDS_WAIT(); asm volatile("" ::: "memory");
            const bool rf = kb + 2 < 8; const int kn = rf ? kb + 2 : 7;
#pragma unroll
            for (int d = 0; d < 8; ++d) {
                oacc[d] = MFMA16(vf_[d], pf, oacc[d]);
                SCHED_FENCE();
                if (rf) { DSA_VDMA1(kn, d); }
                SCHED_FENCE();
            }
            lacc = MFMA16(ones, pf, lacc);
        }
#undef DSA_KDMA1
#undef DSA_VDMA1
#undef DSA_KDMA
#undef DSA_VDMA
        if (c16 < 3) { const float il_ = 1.f / lacc[0]; bf16* orow = mix + m * MIXW + MIX_DSA + (n * 3 + c16) * 128 + 4 * kq;
#pragma unroll
            for (int d = 0; d < 8; ++d) *(GAS v2u*)(orow + 16 * d) = (v2u){cvtpk_s(oacc[d][0] * il_, oacc[d][1] * il_), cvtpk_s(oacc[d][2] * il_, oacc[d][3] * il_)}; }
        asm volatile("s_waitcnt vmcnt(0) lgkmcnt(0)" ::: "memory");
    }
}

struct Args { const float* in[12]; float* out; unsigned char* ws; };
__device__ __forceinline__ void grid_bar(LAS unsigned char* lds, const int wave_s) {
    XcdBarrier b; b.bar = (unsigned*)(KA_WS() + WS_CTL) + CW_BAR; b.x = xb_xcc_id(); b.st = (volatile LAS unsigned*)(lds + MISC_OFF) + 8;
    xcd_barrier(b, tid_now(wave_s));
}
__global__ void __launch_bounds__(NWAVES * 64, 2) fwd_kernel(Args args) {
    extern __shared__ __attribute__((aligned(16))) unsigned char lds_raw[];
    LAS unsigned char* lds = (LAS unsigned char*)lds_raw;
    const int wave_s = __builtin_amdgcn_readfirstlane((int)threadIdx.x >> 6);
    for (int u = threadIdx.x; u < (LDS_BYTES - LDSCTL_OFF) / 4; u += NWAVES * 64) ((LAS unsigned*)(lds + LDSCTL_OFF))[u] = 0u;
    __syncthreads();
    (void)xcd_barrier_post((unsigned*)(KA_WS() + WS_CTL) + CW_BAR, (volatile LAS unsigned*)(lds + MISC_OFF) + 8);
#define GRID_BAR() grid_bar(lds, wave_s)
#define WSP(T_, off) ((T_*)(ws + (off)))

    p0_prologue(lds, wave_s);
    GRID_BAR();

#pragma unroll 1
    for (int l = 0; l < DEPTH; ++l) {
        const int Gg = inproj_gemm_wgs(NWG);
        if ((int)blockIdx.x >= Gg) side_convert(lds, wave_s, l, (int)blockIdx.x - Gg, NWG - Gg);
        else
        { unsigned char* ws = KA_WS(); unsigned char* wl = ws + WS_W + (size_t)l * SZ_WLAYER;
          pg8::Gemm g{WSP(bf16, WS_U), (const bf16*)(wl + OFF_WIN), M, NIN, DM}; pg8::StaticOrder S; S.init(M, NIN, Gg, (int)blockIdx.x);
          pg8::EpiBf16<0> E{WSP(bf16, WS_PROJ), NIN, 0, (const float*)(ws + WS_CTL) + CW_ROWSS + (size_t)(2 * l) * M, 1.0f / DM};
          pg8::gemm_phase<pg8::EpiBf16<0>, pg8::StaticOrder, true, true>(lds + RING_OFF, g, S, E, tid_now(wave_s)); }
        if (Gg == NWG) side_convert(lds, wave_s, l, (int)blockIdx.x, NWG);
        GRID_BAR();
        prep_phase(lds, wave_s, l);
        GRID_BAR();
        { unsigned char* ws = KA_WS(); unsigned char* wl = ws + WS_W + (size_t)l * SZ_WLAYER;
          pg8::Gemm g{WSP(bf16, WS_CQN), (const bf16*)(wl + OFF_WUQ), M, NUQ, QL}; pg8::StaticOrder S; S.init(M, NUQ, NWG, (int)((blockIdx.x + NWG / 2) % NWG));
          pg8::EpiBf16<0> E{WSP(bf16, WS_QMLA), NUQ, 0, nullptr, 0.f};
          pg8::gemm_phase<pg8::EpiBf16<0>, pg8::StaticOrder, true, true>(lds + RING_OFF, g, S, E, tid_now(wave_s)); }
        { unsigned char* ws = KA_WS(); unsigned char* wl = ws + WS_W + (size_t)l * SZ_WLAYER;
          pg8::Gemm g{WSP(bf16, WS_CKVN), (const bf16*)(wl + OFF_WUKV), M, NUKV, KVL}; pg8::StaticOrder S; S.init(M, NUKV, NWG, (int)blockIdx.x);
          pg8::EpiBf16<0> E{WSP(bf16, WS_KVMLA), 256, (size_t)M * 256, nullptr, 0.f};
          pg8::gemm_phase<pg8::EpiBf16<0>, pg8::StaticOrder, true, true>(lds + RING_OFF, g, S, E, tid_now(wave_s)); }
        __syncthreads();
        indexer_mfma(lds, wave_s);
        attn_phase<2>(lds, wave_s, l);
        GRID_BAR();
        if ((int)blockIdx.x >= NWG - ATT_CONV) wdn_convert(lds, wave_s, l, (int)blockIdx.x - (NWG - ATT_CONV));
        attn_phase<0>(lds, wave_s, l);
        attn_phase<1>(lds, wave_s, l);
        dsa_fast(lds, wave_s, l);
        GRID_BAR();
        { unsigned char* ws = KA_WS(); unsigned char* wl = ws + WS_W + (size_t)l * SZ_WLAYER;
          pg8::Gemm g{WSP(bf16, WS_MIX), (const bf16*)(wl + OFF_WO), M, DM, MIXW}; pg8::StaticOrder S; S.init(M, DM, NWG, (int)blockIdx.x);
          pg8::EpiRes E{l == 0 ? KA_IN(0) : (const float*)nullptr, (float*)nullptr, DM, WSP(bf16, WS_U), (float*)(ws + WS_CTL) + CW_ROWSS + (size_t)(2 * l + 1) * M};
          pg8::gemm_phase<pg8::EpiRes, pg8::StaticOrder, true, true>(lds + RING_OFF, g, S, E, tid_now(wave_s)); }
        GRID_BAR();
        { unsigned char* ws = KA_WS(); unsigned char* wl = ws + WS_W + (size_t)l * SZ_WLAYER;
          pg8::Gemm g{WSP(bf16, WS_U), (const bf16*)(wl + OFF_WUP), M, FF, DM}; pg8::StaticOrder S; S.init(M, FF, NWG, (int)blockIdx.x);
          pg8::EpiBf16<1> E{WSP(bf16, WS_HID), FF, 0, (const float*)(ws + WS_CTL) + CW_ROWSS + (size_t)(2 * l + 1) * M, 1.0f / DM};
          pg8::gemm_phase<pg8::EpiBf16<1>, pg8::StaticOrder, true, true>(lds + RING_OFF, g, S, E, tid_now(wave_s)); }
        GRID_BAR();
        if (l + 1 < DEPTH)
        { unsigned char* ws = KA_WS(); unsigned char* wl = ws + WS_W + (size_t)l * SZ_WLAYER;
          pg8::Gemm g{WSP(bf16, WS_HID), (const bf16*)(wl + OFF_WDN), M, DM, FF}; pg8::StaticOrder S; S.init(M, DM, NWG, (int)blockIdx.x);
          pg8::EpiRes E{(const float*)nullptr, (float*)nullptr, DM, WSP(bf16, WS_U), (float*)(ws + WS_CTL) + CW_ROWSS + (size_t)(2 * l + 2) * M};
          pg8::gemm_phase<pg8::EpiRes, pg8::StaticOrder, true, true>(lds + RING_OFF, g, S, E, tid_now(wave_s));
          GRID_BAR(); }
        else
        { unsigned char* ws = KA_WS(); unsigned char* wl = ws + WS_W + (size_t)l * SZ_WLAYER;
          pg8::Gemm g{WSP(bf16, WS_HID), (const bf16*)(wl + OFF_WDN), M, DM, FF}; pg8::FinalOrder S; S.init(M, DM, NWG, (int)blockIdx.x);
          pg8::EpiFinal E{WSP(bf16, WS_U), KA_OUT(), DM, (float*)(ws + WS_CTL) + CW_ROWSS + (size_t)(2 * l + 2) * M, KA_IN(11), queue_word(ws, 2, 0)};
          pg8::gemm_phase<pg8::EpiFinal, pg8::FinalOrder, true, true>(lds + RING_OFF, g, S, E, tid_now(wave_s)); }
    }
}

extern "C" void kernel_launch(void* const* d_in, const int* in_sizes, int n_in, void* d_out, int out_size, void* d_ws, size_t ws_size, hipStream_t stream) {
    static int grid = 0;
    if (grid == 0) {
        if (n_in != 12 || in_sizes[0] != M * DM || out_size != M * DM || ws_size < WS_END) {
            fprintf(stderr, "kernel_launch: unexpected shapes (n_in %d in0 %d out %d ws %zu need %zu); nothing launched\n", n_in, n_in > 0 ? in_sizes[0] : -1, out_size, ws_size, (size_t)WS_END); grid = -1; return; }
        int dev = 0, cus = 0, per_cu = 0;
        if (hipGetDevice(&dev) != hipSuccess || hipDeviceGetAttribute(&cus, hipDeviceAttributeMultiprocessorCount, dev) != hipSuccess) { grid = -1; return; }
        if (hipFuncSetAttribute((const void*)fwd_kernel, hipFuncAttributeMaxDynamicSharedMemorySize, LDS_BYTES) != hipSuccess) { fprintf(stderr, "kernel_launch: hipFuncSetAttribute failed\n"); grid = -1; return; }
        if (hipOccupancyMaxActiveBlocksPerMultiprocessor(&per_cu, (const void*)fwd_kernel, NWAVES * 64, LDS_BYTES) != hipSuccess || per_cu < 1)
            fprintf(stderr, "kernel_launch: note: occupancy query reports %d workgroups per CU\n", per_cu);
        (void)hipGetLastError();
        if (cus != NWG) { fprintf(stderr, "kernel_launch: %d CUs, this kernel is built for %d; nothing launched\n", cus, NWG); grid = -1; return; }
        grid = NWG;
    }
    if (grid < 0) return;
    if (hipMemsetAsync((char*)d_ws + WS_CTL, 0, CTL_ZERO_BYTES, stream) != hipSuccess) return;
    Args a{};
    for (int i = 0; i < 12; ++i) a.in[i] = (const float*)d_in[i];
    a.out = (float*)d_out; a.ws = (unsigned char*)d_ws;
    hipLaunchKernelGGL(fwd_kernel, dim3(grid), dim3(NWAVES * 64), LDS_BYTES, stream, a);
    const hipError_t le = hipPeekAtLastError();
    if (le != hipSuccess) fprintf(stderr, "kernel_launch: launch failed: %s\n", hipGetErrorName(le));
}
```

```cpp
#include <hip/hip_runtime.h>
#include <cstdio>
#include <cstdint>
namespace pg8 {
#define PG8_LAS __attribute__((address_space(3)))
typedef unsigned short bf16_t;
typedef short bf16x8 __attribute__((ext_vector_type(8)));
typedef float f32x4 __attribute__((ext_vector_type(4)));
typedef unsigned u32x4 __attribute__((ext_vector_type(4)));
constexpr int BM = 256, BK = 64, HALF = 128, HTB = HALF * BK * 2  , STAGE_BYTES = 8 * HTB, NXCD = 8, WGM = 8;

__host__ __device__ __forceinline__ int lds_byte(int r, int c) { const int st = (r >> 4) * 2 + (c >> 5), rr = r & 15, cc = c & 31, ob = rr * 64 + cc * 2; return st * 1024 + (ob ^ (((ob >> 9) & 1) << 5)); }
__host__ __device__ __forceinline__ void stage_rc(int b, int& R, int& C) { const int st = b / 1024, sb = b % 1024, swz = sb ^ (((sb >> 9) & 1) << 5); R = (st >> 1) * 16 + swz / 64; C = (st & 1) * 32 + (swz % 64) / 2; }
__host__ __device__ __forceinline__ int perm32(int rho) { const int n = rho >> 4, i = rho & 15; return 8 * (i >> 2) + 4 * n + (i & 3); }

struct Unit { int pm, pn; };
struct Gemm { const bf16_t* A; const bf16_t* Bt; int M, N, K; };

struct StaticOrder {
    int nM, nN, nwg, G, c;
    __host__ __device__ void init(int M, int N, int G_, int c_) { nM = M / BM; nN = N / BM; nwg = nM * nN; G = G_; c = c_; }
    __host__ __device__ bool next(int i, Unit& u) const {
        const long L = (long)i * G + c; if (L >= nwg) return false;
        int wgid = (int)L; { const int q = nwg / NXCD, r = nwg % NXCD, xcd = wgid % NXCD, off = wgid / NXCD; wgid = (xcd < r ? xcd * (q + 1) : r * (q + 1) + (xcd - r) * q) + off; }
        const int nig = WGM * nN, gid = wgid / nig, fm = gid * WGM, gsz = (nM - fm) < WGM ? (nM - fm) : WGM;
        u.pm = fm + ((wgid % nig) % gsz); u.pn = (wgid % nig) / gsz; return true;
    }
    __device__ __forceinline__ void a_ready(const Unit&) const {}
    __device__ __forceinline__ void done(const Unit&) const {}
};

__device__ __forceinline__ unsigned cvt_pk_bf16(float lo, float hi) { unsigned r; asm volatile("v_cvt_pk_bf16_f32 %0, %1, %2" : "=v"(r) : "v"(lo), "v"(hi)); return r; }
typedef float f32x2 __attribute__((ext_vector_type(2)));
template <int ACT  > struct EpiBf16 {
    static constexpr bool PERM = true, AFTER_DRAIN = false;
    bf16_t* O; int ldc; size_t tile_stride;
    const float* rowss; float inv_k;
    __device__ __forceinline__ void operator()(const f32x4 (&acc)[2][2][4][2], const Unit& u, int wr, int wc, int fr, int fq) const {
        const int rb0 = u.pm * BM + wr * 64; const int colx = (tile_stride ? 0 : u.pn * BM) + wc * 64 + 8 * fq + (fr >> 3) * 32; const bool lo = fr < 8;
        bf16_t* Ob = O + (size_t)u.pn * tile_stride;
#pragma unroll
        for (int ai = 0; ai < 2; ++ai)
#pragma unroll
            for (int m = 0; m < 4; ++m) { const int rbase = rb0 + ai * HALF + m * 16;
                const float rs = rowss ? 1.0f / sqrtf(rowss[rbase + fr] * inv_k + 1e-6f) : 1.0f;
                u32x4 w[2];
#pragma unroll
                for (int bj = 0; bj < 2; ++bj) { f32x4 v0 = acc[ai][bj][m][0] * rs, v1 = acc[ai][bj][m][1] * rs;
                    if (ACT == 1) {
#pragma unroll
                        for (int j = 0; j < 4; ++j) { const float a = fmaxf(v0[j], 0.f), b = fmaxf(v1[j], 0.f); v0[j] = a * a; v1[j] = b * b; } }
                    w[bj].x = cvt_pk_bf16(v0[0], v0[1]); w[bj].y = cvt_pk_bf16(v0[2], v0[3]); w[bj].z = cvt_pk_bf16(v1[0], v1[1]); w[bj].w = cvt_pk_bf16(v1[2], v1[3]); }
                u32x4 t, r_, d1, d2;
                t.x = lo ? w[1].x : w[0].x; t.y = lo ? w[1].y : w[0].y; t.z = lo ? w[1].z : w[0].z; t.w = lo ? w[1].w : w[0].w;
                r_.x = (unsigned)__builtin_amdgcn_update_dpp(0, (int)t.x, 0x128, 0xf, 0xf, false); r_.y = (unsigned)__builtin_amdgcn_update_dpp(0, (int)t.y, 0x128, 0xf, 0xf, false);
                r_.z = (unsigned)__builtin_amdgcn_update_dpp(0, (int)t.z, 0x128, 0xf, 0xf, false); r_.w = (unsigned)__builtin_amdgcn_update_dpp(0, (int)t.w, 0x128, 0xf, 0xf, false);
                d1.x = lo ? w[0].x : r_.x; d1.y = lo ? w[0].y : r_.y; d1.z = lo ? w[0].z : r_.z; d1.w = lo ? w[0].w : r_.w;
                d2.x = lo ? r_.x : w[1].x; d2.y = lo ? r_.y : w[1].y; d2.z = lo ? r_.z : w[1].z; d2.w = lo ? r_.w : w[1].w;
                bf16_t* p1 = Ob + (size_t)(rbase + (fr & 7)) * ldc + colx; bf16_t* p2 = p1 + (size_t)8 * ldc;
                *(u32x4*)p1 = d1; *(u32x4*)p2 = d2; }
    }
};
struct EpiRes {
    static constexpr bool PERM = true, AFTER_DRAIN = false;
    const float* base32; float* out32; int ldc; bf16_t* hb; float* rowss;
    __device__ __forceinline__ void operator()(const f32x4 (&acc)[2][2][4][2], const Unit& u, int wr, int wc, int fr, int fq) const {
        const int row0 = u.pm * BM + wr * 64 + fr, col0 = u.pn * BM + wc * 64 + 8 * fq;
#pragma unroll
        for (int ai = 0; ai < 2; ++ai)
#pragma unroll
            for (int m = 0; m < 4; ++m) { const int r = row0 + ai * HALF + m * 16; const size_t off = (size_t)r * ldc + col0; float ss = 0.f;
#pragma unroll
                for (int bj = 0; bj < 2; ++bj) { const size_t o1 = off + bj * 32; f32x4 b0, b1;
                    if (base32) { b0 = *(const f32x4*)(base32 + o1); b1 = *(const f32x4*)(base32 + o1 + 4); }
                    else { const u32x4 w = *(const u32x4*)(hb + o1);
                        b0 = (f32x4){__builtin_bit_cast(float, w.x << 16), __builtin_bit_cast(float, w.x & 0xffff0000u), __builtin_bit_cast(float, w.y << 16), __builtin_bit_cast(float, w.y & 0xffff0000u)};
                        b1 = (f32x4){__builtin_bit_cast(float, w.z << 16), __builtin_bit_cast(float, w.z & 0xffff0000u), __builtin_bit_cast(float, w.w << 16), __builtin_bit_cast(float, w.w & 0xffff0000u)}; }
                    const f32x4 o0 = b0 + acc[ai][bj][m][0], o1v = b1 + acc[ai][bj][m][1];
                    if (out32) { __builtin_nontemporal_store(o0, (f32x4*)(out32 + o1)); __builtin_nontemporal_store(o1v, (f32x4*)(out32 + o1 + 4)); }
                    else { ss += ((o0[0] * o0[0] + o0[1] * o0[1]) + (o0[2] * o0[2] + o0[3] * o0[3])) + ((o1v[0] * o1v[0] + o1v[1] * o1v[1]) + (o1v[2] * o1v[2] + o1v[3] * o1v[3]));
                        u32x4 w; w.x = cvt_pk_bf16(o0[0], o0[1]); w.y = cvt_pk_bf16(o0[2], o0[3]); w.z = cvt_pk_bf16(o1v[0], o1v[1]); w.w = cvt_pk_bf16(o1v[2], o1v[3]); *(u32x4*)(hb + o1) = w; } }
                if (!out32) { ss += __shfl_xor(ss, 16); ss += __shfl_xor(ss, 32);
                    if (fq == 0) __hip_atomic_fetch_add(rowss + r, ss, __ATOMIC_RELAXED, __HIP_MEMORY_SCOPE_AGENT); } }
    }
};
struct EpiFinal {
    static constexpr bool PERM = true, AFTER_DRAIN = false;
    const bf16_t* hb; float* out; int ldc; float* rowss; const float* gfin; unsigned* cnt;
    __device__ __forceinline__ void operator()(const f32x4 (&acc)[2][2][4][2], const Unit& u, int wr, int wc, int fr, int fq) const {
        const int row0 = u.pm * BM + wr * 64 + fr, col0 = u.pn * BM + wc * 64 + 8 * fq;
#pragma unroll
        for (int ai = 0; ai < 2; ++ai)
#pragma unroll
            for (int m = 0; m < 4; ++m) { const int r = row0 + ai * HALF + m * 16; const size_t off = (size_t)r * ldc + col0; float ss = 0.f;
#pragma unroll
                for (int bj = 0; bj < 2; ++bj) { const u32x4 w = *(const u32x4*)(hb + off + bj * 32);
                    const f32x4 b0 = (f32x4){__builtin_bit_cast(float, w.x << 16), __builtin_bit_cast(float, w.x & 0xffff0000u), __builtin_bit_cast(float, w.y << 16), __builtin_bit_cast(float, w.y & 0xffff0000u)};
                    const f32x4 b1 = (f32x4){__builtin_bit_cast(float, w.z << 16), __builtin_bit_cast(float, w.z & 0xffff0000u), __builtin_bit_cast(float, w.w << 16), __builtin_bit_cast(float, w.w & 0xffff0000u)};
                    const f32x4 o0 = b0 + acc[ai][bj][m][0], o1v = b1 + acc[ai][bj][m][1];
                    ss += ((o0[0] * o0[0] + o0[1] * o0[1]) + (o0[2] * o0[2] + o0[3] * o0[3])) + ((o1v[0] * o1v[0] + o1v[1] * o1v[1]) + (o1v[2] * o1v[2] + o1v[3] * o1v[3])); }
                ss += __shfl_xor(ss, 16); ss += __shfl_xor(ss, 32);
                if (fq == 0) __hip_atomic_fetch_add(rowss + r, ss, __ATOMIC_RELAXED, __HIP_MEMORY_SCOPE_AGENT); }
        asm volatile("s_waitcnt vmcnt(0)" ::: "memory");
        unsigned* c = cnt + u.pm * 64;
        if (fr == 0 && fq == 0) { __hip_atomic_fetch_add(c, 1u, __ATOMIC_RELAXED, __HIP_MEMORY_SCOPE_AGENT);
            int spins = 0; while (__hip_atomic_load(c, __ATOMIC_RELAXED, __HIP_MEMORY_SCOPE_AGENT) < 128u && ++spins < (1 << 22)) __builtin_amdgcn_s_sleep(2); }
        asm volatile("" ::: "memory");
#pragma unroll
        for (int ai = 0; ai < 2; ++ai)
#pragma unroll
            for (int m = 0; m < 4; ++m) { const int r = row0 + ai * HALF + m * 16; const size_t off = (size_t)r * ldc + col0;
                const float rs = 1.0f / sqrtf(__hip_atomic_load(rowss + r, __ATOMIC_RELAXED, __HIP_MEMORY_SCOPE_AGENT) * (1.0f / 4096.0f) + 1e-6f);
#pragma unroll
                for (int bj = 0; bj < 2; ++bj) { const size_t o1 = off + bj * 32; const u32x4 w = *(const u32x4*)(hb + o1);
                    const f32x4 b0 = (f32x4){__builtin_bit_cast(float, w.x << 16), __builtin_bit_cast(float, w.x & 0xffff0000u), __builtin_bit_cast(float, w.y << 16), __builtin_bit_cast(float, w.y & 0xffff0000u)};
                    const f32x4 b1 = (f32x4){__builtin_bit_cast(float, w.z << 16), __builtin_bit_cast(float, w.z & 0xffff0000u), __builtin_bit_cast(float, w.w << 16), __builtin_bit_cast(float, w.w & 0xffff0000u)};
                    const f32x4 g0 = *(const f32x4*)(gfin + col0 + bj * 32), g1 = *(const f32x4*)(gfin + col0 + bj * 32 + 4);
                    __builtin_nontemporal_store(((b0 + acc[ai][bj][m][0]) * rs) * g0, (f32x4*)(out + o1)); __builtin_nontemporal_store(((b1 + acc[ai][bj][m][1]) * rs) * g1, (f32x4*)(out + o1 + 4)); } }
    }
};
struct FinalOrder {
    int c;
    __host__ __device__ void init(int, int, int, int c_) { c = c_; }
    __host__ __device__ bool next(int i, Unit& u) const { if (i >= 2) return false; const int x = c & 7, j = c >> 3; u.pm = 16 * i + 8 * (x & 1) + (j & 7); u.pn = 4 * (x >> 1) + (j >> 3); return true; }
    __device__ __forceinline__ void a_ready(const Unit&) const {}
    __device__ __forceinline__ void done(const Unit&) const {}
};
template <class Epi, class Sched, bool ALIGN_EPI = false, bool SP2 = false>
__device__ __forceinline__ void gemm_phase(PG8_LAS unsigned char* lds, const Gemm g, const Sched& S, const Epi& E, const int tid_arg) {
    int tid_ = tid_arg; asm volatile("" : "+v"(tid_));
    const int tid = tid_, wid = __builtin_amdgcn_readfirstlane(tid >> 6), lane = tid & 63, wr = wid >> 2, wc = wid & 3, fr = lane & 15, fq = lane >> 4;
    const int K = g.K, nt = K / BK;
    unsigned voffA[2], voffB[2];
#pragma unroll
    for (int i = 0; i < 2; ++i) { int R, C; stage_rc(tid * 16 + i * 8192, R, C); const int Rb = Epi::PERM ? ((R >> 5) * 64 + perm32(R & 31)) : R;
        voffA[i] = (unsigned)(R * K + C) * 2u; voffB[i] = (unsigned)(Rb * K + C) * 2u; }
    const size_t kstep = (size_t)(BK * 2);
    const size_t hstep = (size_t)HALF * K * 2;
    const size_t tstep = 2 * hstep;
    const size_t hstepB = Epi::PERM ? (size_t)32 * K * 2 : hstep;
    const unsigned ldsw = (unsigned)wid * 1024u;
    const int aoff = lds_byte(wr * 64 + fr, fq * 8), boff = lds_byte(wc * 32 + fr, fq * 8);
#define PG8_SA(b, h) (((b) * 2 + (h)) * HTB)
#define PG8_SB(b, h) ((4 + (b) * 2 + (h)) * HTB)
#define PG8_STAGE(bufoff, gbase, voff) do { _Pragma("unroll") for (int _i = 0; _i < 2; ++_i) \
        __builtin_amdgcn_global_load_lds((const unsigned*)((const char*)(gbase) + (voff)[_i]), (PG8_LAS unsigned*)(lds + (bufoff) + ldsw + _i * 8192), 16, 0, 0); } while (0)
#define PG8_LDA(dst, b, h) do { _Pragma("unroll") for (int m = 0; m < 4; ++m) _Pragma("unroll") for (int k = 0; k < 2; ++k) dst[m][k] = *(const PG8_LAS bf16x8*)(lds + PG8_SA(b, h) + aoff + m * 2048 + k * 1024); } while (0)
#define PG8_LDB(dst, b, h) do { _Pragma("unroll") for (int n = 0; n < 2; ++n) _Pragma("unroll") for (int k = 0; k < 2; ++k) dst[n][k] = *(const PG8_LAS bf16x8*)(lds + PG8_SB(b, h) + boff + n * 2048 + k * 1024); } while (0)
#define PG8_MMA(ai, bj, At, Bt) do { __builtin_amdgcn_s_setprio(1); _Pragma("unroll") for (int m = 0; m < 4; ++m) _Pragma("unroll") for (int n = 0; n < 2; ++n) _Pragma("unroll") for (int k = 0; k < 2; ++k) \
        acc[ai][bj][m][n] = __builtin_amdgcn_mfma_f32_16x16x32_bf16(Bt[n][k], At[m][k], acc[ai][bj][m][n], 0, 0, 0); __builtin_amdgcn_s_setprio(0); } while (0)
#define PG8_WAIT_V(n) asm volatile("s_waitcnt vmcnt(" #n ")" ::: "memory")
#define PG8_WAIT_L(n) asm volatile("s_waitcnt lgkmcnt(" #n ")" ::: "memory")
#define PG8_BAR __builtin_amdgcn_s_barrier()
#define PG8_SCHED __builtin_amdgcn_sched_barrier(0)
    Unit cur, nxt; int ui = 0;
    if (!S.next(0, cur)) return;
    f32x4 acc[2][2][4][2];
#pragma unroll
    for (int a = 0; a < 2; ++a)
#pragma unroll
        for (int b = 0; b < 2; ++b)
#pragma unroll
            for (int m = 0; m < 4; ++m)
#pragma unroll
                for (int n = 0; n < 2; ++n) acc[a][b][m][n] = (f32x4){0.f, 0.f, 0.f, 0.f};
    bf16x8 At[4][2], B0[2][2], B1[2][2];
    const char* cA = (const char*)g.A + (size_t)cur.pm * tstep; const char* cB = (const char*)g.Bt + (size_t)cur.pn * tstep;
    S.a_ready(cur);
    if constexpr (SP2) {
        PG8_STAGE(PG8_SB(0, 0), cB, voffB); PG8_STAGE(PG8_SB(0, 1), cB + hstepB, voffB); PG8_STAGE(PG8_SA(0, 0), cA, voffA); PG8_STAGE(PG8_SA(0, 1), cA + hstep, voffA);
        if (wr == 1) PG8_BAR;
        PG8_WAIT_V(2); PG8_BAR;
        PG8_STAGE(PG8_SB(1, 0), cB + kstep, voffB); PG8_STAGE(PG8_SA(1, 0), cA + kstep, voffA); PG8_STAGE(PG8_SB(1, 1), cB + hstepB + kstep, voffB);
        PG8_WAIT_V(6); PG8_BAR;
    } else {
        PG8_STAGE(PG8_SB(0, 0), cB, voffB); PG8_STAGE(PG8_SA(0, 0), cA, voffA); PG8_STAGE(PG8_SB(0, 1), cB + hstepB, voffB); PG8_STAGE(PG8_SA(0, 1), cA + hstep, voffA);
        if (wr == 1) PG8_BAR;
        PG8_WAIT_V(4); PG8_BAR;
        PG8_STAGE(PG8_SB(1, 0), cB + kstep, voffB); PG8_STAGE(PG8_SA(1, 0), cA + kstep, voffA); PG8_STAGE(PG8_SB(1, 1), cB + hstepB + kstep, voffB);
        PG8_WAIT_V(6); PG8_BAR;
    }
    for (;;) {
        const bool has_next = S.next(ui + 1, nxt);
        const char* nA = has_next ? (const char*)g.A + (size_t)nxt.pm * tstep : cA; const char* nB = has_next ? (const char*)g.Bt + (size_t)nxt.pn * tstep : cB;
        for (int t = 0; t < nt; t += 2) {
            const bool last = (t == nt - 2);
            const char* a1 = cA + (size_t)(t + 1) * kstep;
            const char* a2 = last ? nA : cA + (size_t)(t + 2) * kstep; const char* b2 = last ? nB : cB + (size_t)(t + 2) * kstep;
            const char* a3 = a2 + kstep; const char* b3 = b2 + kstep;
            if (last && has_next) S.a_ready(nxt);
            if constexpr (SP2) {
            PG8_LDB(B0, 0, 0); PG8_LDB(B1, 0, 1); PG8_SCHED; PG8_LDA(At, 0, 0); PG8_STAGE(PG8_SA(1, 1), a1 + hstep, voffA);
            PG8_WAIT_V(8); PG8_WAIT_L(0); PG8_BAR; PG8_MMA(0, 0, At, B0); PG8_MMA(0, 1, At, B1); PG8_BAR; PG8_SCHED;
            PG8_LDA(At, 0, 1); PG8_STAGE(PG8_SB(0, 0), b2, voffB); PG8_STAGE(PG8_SB(0, 1), b2 + hstepB, voffB); PG8_STAGE(PG8_SA(0, 0), a2, voffA);
            PG8_WAIT_V(8); PG8_WAIT_L(0); PG8_BAR; PG8_MMA(1, 0, At, B0); PG8_MMA(1, 1, At, B1); PG8_BAR; PG8_SCHED;
            PG8_LDB(B0, 1, 0); PG8_LDB(B1, 1, 1); PG8_SCHED; PG8_LDA(At, 1, 0); PG8_STAGE(PG8_SA(0, 1), a2 + hstep, voffA);
            PG8_WAIT_V(8); PG8_WAIT_L(0); PG8_BAR; PG8_MMA(0, 0, At, B0); PG8_MMA(0, 1, At, B1); PG8_BAR; PG8_SCHED;
            PG8_LDA(At, 1, 1); PG8_STAGE(PG8_SB(1, 0), b3, voffB); PG8_STAGE(PG8_SB(1, 1), b3 + hstepB, voffB); PG8_STAGE(PG8_SA(1, 0), a3, voffA);
            PG8_WAIT_V(8); PG8_WAIT_L(0); PG8_BAR; PG8_MMA(1, 0, At, B0); PG8_MMA(1, 1, At, B1); PG8_BAR; PG8_SCHED;
            } else {
            PG8_LDB(B0, 0, 0); PG8_SCHED; PG8_LDA(At, 0, 0); PG8_STAGE(PG8_SA(1, 1), a1 + hstep, voffA);
            PG8_WAIT_L(8); PG8_BAR; PG8_WAIT_L(0); PG8_MMA(0, 0, At, B0); PG8_BAR; PG8_SCHED;
            PG8_LDB(B1, 0, 1); PG8_STAGE(PG8_SB(0, 0), b2, voffB);
            PG8_BAR; PG8_WAIT_L(0); PG8_MMA(0, 1, At, B1); PG8_BAR;
            PG8_LDA(At, 0, 1); PG8_STAGE(PG8_SA(0, 0), a2, voffA);
            PG8_BAR; PG8_WAIT_L(0); PG8_MMA(1, 0, At, B0); PG8_BAR; PG8_SCHED;
            PG8_STAGE(PG8_SB(0, 1), b2 + hstepB, voffB);
            PG8_WAIT_V(6); PG8_BAR; PG8_MMA(1, 1, At, B1); PG8_BAR;
            PG8_LDB(B0, 1, 0); PG8_SCHED; PG8_LDA(At, 1, 0); PG8_STAGE(PG8_SA(0, 1), a2 + hstep, voffA);
            PG8_WAIT_L(8); PG8_BAR; PG8_WAIT_L(0); PG8_MMA(0, 0, At, B0); PG8_BAR; PG8_SCHED;
            PG8_LDB(B1, 1, 1); PG8_STAGE(PG8_SB(1, 0), b3, voffB);
            PG8_BAR; PG8_WAIT_L(0); PG8_MMA(0, 1, At, B1); PG8_BAR;
            PG8_LDA(At, 1, 1); PG8_STAGE(PG8_SA(1, 0), a3, voffA);
            PG8_BAR; PG8_WAIT_L(0); PG8_MMA(1, 0, At, B0); PG8_BAR; PG8_SCHED;
            PG8_STAGE(PG8_SB(1, 1), b3 + hstepB, voffB);
            PG8_WAIT_V(6); PG8_BAR; PG8_MMA(1, 1, At, B1); PG8_BAR;
            }
        }
        if constexpr (ALIGN_EPI) { if (wr == 0) PG8_BAR; }
        if constexpr (!Epi::AFTER_DRAIN) { E(acc, cur, wr, wc, fr, fq); S.done(cur); }
        if (!has_next) break;
#pragma unroll
        for (int a = 0; a < 2; ++a)
#pragma unroll
            for (int b = 0; b < 2; ++b)
#pragma unroll
                for (int m = 0; m < 4; ++m)
#pragma unroll
                    for (int n = 0; n < 2; ++n) acc[a][b][m][n] = (f32x4){0.f, 0.f, 0.f, 0.f};
        cur = nxt; cA = nA; cB = nB; ++ui;
        if constexpr (ALIGN_EPI) { if (wr == 1) PG8_BAR; }
    }
    PG8_WAIT_V(0);
    if constexpr (!ALIGN_EPI) { if (wr == 0) PG8_BAR; }
    PG8_BAR;
    if constexpr (Epi::AFTER_DRAIN) { E.fused(acc, cur, wr, wc, fr, fq, lds, wid, lane); S.done(cur); }
#undef PG8_SA
#undef PG8_SB
#undef PG8_STAGE
#undef PG8_LDA
#undef PG8_LDB
#undef PG8_MMA
#undef PG8_WAIT_V
#undef PG8_WAIT_L
#undef PG8_BAR
#undef PG8_SCHED
}
}

constexpr int NWAVES = 8;
constexpr int NWG = 256;
constexpr int BATCH = 2, T = 4096, DM = 4096, DEPTH = 2, M = BATCH * T, FF = 4 * DM;
constexpr int NIN_ORIG = 10976, NIN = 11008;
constexpr int C_RQ = 0, C_RK = 512, C_RV = 1024, C_RG = 2048, C_DQ = 3072, C_DK = 4608, C_DV = 5120, C_IQ = 5632, C_IK = 9728, C_IW = 9856,
              C_KR = 9888, C_PAD = 9952, C_CQ = 9984, C_CKV = 10752;
constexpr int O_CQ = 9888, O_CKV = 10656, O_KR = 10912;
constexpr int QL = 768, KVL = 256, NUQ = 2304, NUKV = 3072;
constexpr int MIXW = 4096, MIX_RET = 0, MIX_DSA = 1024, MIX_MLA = 2560;
constexpr float NORM_EPS = 1e-6f;
constexpr int TOPK = 256;

constexpr size_t MiB = 1u << 20;
constexpr size_t WS_CTL = 0, CTL_ZERO_BYTES = 1 * MiB;
constexpr size_t WS_TABA = 1 * MiB;
constexpr size_t WS_TABB = 2 * MiB;
constexpr size_t WS_W = 4 * MiB;
constexpr size_t SZ_WIN = (size_t)NIN * DM * 2, SZ_WUQ = (size_t)NUQ * QL * 2, SZ_WUKV = (size_t)NUKV * KVL * 2, SZ_WO = (size_t)DM * MIXW * 2, SZ_WUP = (size_t)FF * DM * 2, SZ_WDN = (size_t)DM * FF * 2;
constexpr size_t OFF_WIN = 0, OFF_WUQ = OFF_WIN + SZ_WIN, OFF_WUKV = OFF_WUQ + SZ_WUQ, OFF_WO = OFF_WUKV + SZ_WUKV, OFF_WUP = OFF_WO + SZ_WO, OFF_WDN = OFF_WUP + SZ_WUP, SZ_WLAYER = OFF_WDN + SZ_WDN;
constexpr size_t WS_H = WS_W + 2 * SZ_WLAYER;
constexpr size_t WS_U = WS_H + (size_t)M * DM * 4;
constexpr size_t WS_PROJ = WS_U + (size_t)M * DM * 2;
constexpr size_t WS_CQN = WS_PROJ + (size_t)M * NIN * 2;
constexpr size_t WS_CKVN = WS_CQN + (size_t)M * QL * 2;
constexpr size_t WS_QMLA = WS_CKVN + (size_t)M * KVL * 2;
constexpr size_t WS_KVMLA = WS_QMLA + (size_t)M * NUQ * 2;
constexpr size_t WS_MIX = WS_KVMLA + (size_t)M * NUKV * 2;
constexpr size_t WS_HID = WS_MIX + (size_t)M * MIXW * 2;
constexpr size_t WS_SEL = WS_HID + (size_t)M * FF * 2;
constexpr size_t WS_ISC = WS_SEL + (size_t)M * TOPK * 4;
constexpr size_t WS_DKC = WS_ISC + (size_t)M * T * 4;
constexpr size_t WS_DVC = WS_DKC + (size_t)M * 512 * 2;
constexpr size_t WS_IKC = WS_DVC + (size_t)M * 512 * 2;
constexpr size_t WS_BU = WS_IKC + (size_t)M * 128 * 2;
constexpr size_t WS_END = WS_BU + (size_t)BATCH * 8 * 16 * 64 * 128 * 4;
static_assert(SZ_WLAYER % 256 == 0 && WS_H % 256 == 0 && WS_PROJ % 256 == 0 && WS_CQN % 256 == 0 && WS_QMLA % 256 == 0 && WS_SEL % 256 == 0, "alignment");

constexpr int CW_TMO = 0, CW_CODE = 1, CW_BAR = 4096;
constexpr int CW_ROWSS = 65536;

constexpr int RING_OFF = 0, RING_BYTES = 131072;
constexpr int LDSCTL_OFF = RING_BYTES, MISC_OFF = LDSCTL_OFF + 320;
constexpr int LDS_BYTES = 163840;
constexpr int XTRA_OFF = RING_BYTES + 1024, XTRA_WAVE = 3968;

#define GAS __attribute__((address_space(1)))
#define LAS __attribute__((address_space(3)))
typedef unsigned short bf16;
typedef unsigned v4u __attribute__((ext_vector_type(4)));
typedef unsigned v2u __attribute__((ext_vector_type(2)));
typedef float f32x4 __attribute__((ext_vector_type(4)));
typedef float f32x2 __attribute__((ext_vector_type(2)));
typedef GAS unsigned gu32;
#define RLX_AGENT __ATOMIC_RELAXED, __HIP_MEMORY_SCOPE_AGENT
#define LDS_WAIT() asm volatile("s_waitcnt lgkmcnt(0)" ::: "memory")
#define VM_WAIT() asm volatile("s_waitcnt vmcnt(0)" ::: "memory")
__device__ __forceinline__ unsigned f2bf(float f) { unsigned u = __builtin_bit_cast(unsigned, f); return (u + 0x7fffu + ((u >> 16) & 1u)) >> 16; }
__device__ __forceinline__ unsigned pk2(float lo, float hi) { return f2bf(lo) | (f2bf(hi) << 16); }
__device__ __forceinline__ float bf2f(unsigned short b) { return __builtin_bit_cast(float, (unsigned)b << 16); }
__device__ __forceinline__ float bflo(unsigned w) { return __builtin_bit_cast(float, w << 16); }
__device__ __forceinline__ float bfhi(unsigned w) { return __builtin_bit_cast(float, w & 0xffff0000u); }
__device__ __forceinline__ float wave_sum(float v) {
#pragma unroll
    for (int o = 1; o < 64; o <<= 1) v += __shfl_xor(v, o);
    return v;
}
__device__ __forceinline__ float wave_max(float v) {
#pragma unroll
    for (int o = 1; o < 64; o <<= 1) v = fmaxf(v, __shfl_xor(v, o));
    return v;
}
__device__ __forceinline__ float rdlane(float v, int l) { return __builtin_bit_cast(float, __builtin_amdgcn_readlane(__builtin_bit_cast(int, v), l)); }

#define XB_TMO      128
#define XB_XCNT(j)  (256  + 64 * (j))
#define XB_XSUB(j)  (1280 + 64 * (j))
#define XB_XGEN(j)  (2304 + 64 * (j))
#define XB_TOP      3328
#define XB_TOPGEN   3392
#define XCD_BAR_WORDS 3456
#define XB_SPIN_CAP (1u << 22)

__device__ __forceinline__ unsigned xb_ld(unsigned* p)              { return __hip_atomic_load(p, __ATOMIC_RELAXED, __HIP_MEMORY_SCOPE_AGENT); }
__device__ __forceinline__ unsigned xb_add(unsigned* p, unsigned v) { return __hip_atomic_fetch_add(p, v, __ATOMIC_RELAXED, __HIP_MEMORY_SCOPE_AGENT); }
__device__ __forceinline__ unsigned xb_xcc_id() { return (unsigned)__builtin_amdgcn_s_getreg((3 << 11) | 20) & 0xFu; }
#define XB_SPIN(cond, bar) do { unsigned _sp = 0; while (cond) { __builtin_amdgcn_s_sleep(1); \
    if ((++_sp & 255u) == 0u) { if (xb_ld(&(bar)[XB_TMO])) break; if (_sp > XB_SPIN_CAP) { atomicAdd(&(bar)[XB_TMO], 1u); break; } } } } while (0)

struct XcdBarrier {
    unsigned* bar; unsigned x;
    volatile LAS unsigned* st;
};

__device__ __forceinline__ XcdBarrier xcd_barrier_post(unsigned* bar, volatile LAS unsigned* st) {
    XcdBarrier b; b.bar = bar; b.x = xb_xcc_id(); b.st = st;
    if (threadIdx.x == 0) (void)xb_add(&bar[XB_XCNT(b.x)], 1u);
    return b;
}
__device__ __forceinline__ void xcd_barrier_complete(unsigned* bar, unsigned x, unsigned& nloc, unsigned& nx) {
    const unsigned G = 256u;
    unsigned sum, cnt, mine, sp = 0u;
    for (;;) {
        sum = 0u; cnt = 0u; mine = 0u;
#pragma unroll
        for (unsigned j = 0; j < 16; ++j) { const unsigned c = xb_ld(&bar[XB_XCNT(j)]); sum += c; cnt += (c > 0u) ? 1u : 0u; mine = (j == x) ? c : mine; }
        if (sum == G) break;
        __builtin_amdgcn_s_sleep(1);
        if ((++sp & 255u) == 0u) { if (xb_ld(&bar[XB_TMO])) break; if (sp > XB_SPIN_CAP) { atomicAdd(&bar[XB_TMO], 1u); break; } }
    }
    nloc = mine > 0u ? mine : 1u; nx = cnt > 0u ? cnt : 1u;
}

__device__ __forceinline__ void xcd_barrier(const XcdBarrier& b, const int tid) {
    asm volatile("s_waitcnt vmcnt(0)" ::: "memory");
    __syncthreads();
    if (tid == 0) {
        unsigned* bar = b.bar;
        __builtin_amdgcn_s_waitcnt(0);
        unsigned nloc = b.st[0], nx = b.st[1];
        if (nloc == 0u) { xcd_barrier_complete(bar, b.x, nloc, nx); b.st[0] = nloc; b.st[1] = nx; }
        const unsigned old = xb_add(&bar[XB_XSUB(b.x)], 1u);
        const unsigned gen = old / nloc;
        if (old + 1u == (gen + 1u) * nloc) {
            __builtin_amdgcn_fence(__ATOMIC_RELEASE, "agent");
            asm volatile("s_waitcnt vmcnt(0)" ::: "memory");
            const unsigned og = xb_add(&bar[XB_TOP], 1u);
            const unsigned tg = og / nx;
            if (og + 1u == (tg + 1u) * nx) xb_add(&bar[XB_TOPGEN], 1u);
            else XB_SPIN(xb_ld(&bar[XB_TOPGEN]) == tg, bar);
            __builtin_amdgcn_fence(__ATOMIC_ACQUIRE, "agent");
            xb_add(&bar[XB_XGEN(b.x)], 1u);
            asm volatile("s_waitcnt vmcnt(0)" ::: "memory");
        } else {
            XB_SPIN(xb_ld(&bar[XB_XGEN(b.x)]) == gen, bar);
            __builtin_amdgcn_fence(__ATOMIC_ACQUIRE, "agent");
            asm volatile("s_waitcnt vmcnt(0)" ::: "memory");
        }
    }
    __syncthreads();
}


__device__ __forceinline__ int lane_now() { int l; asm volatile("v_mbcnt_lo_u32_b32 %0, -1, 0\n\tv_mbcnt_hi_u32_b32 %0, -1, %0" : "=v"(l)); return l; }
__device__ __forceinline__ int tid_now(int wave_s) { return wave_s * 64 + lane_now(); }
template <int OFF> __device__ __forceinline__ unsigned long long karg_u64() {
    unsigned long long v; const unsigned long long ka = (unsigned long long)__builtin_amdgcn_kernarg_segment_ptr();
    asm volatile("s_load_dwordx2 %0, %1, %2\n\ts_waitcnt lgkmcnt(0)" : "=s"(v) : "s"(ka), "i"(OFF) : "memory");
    return v;
}
#define KA_IN(i) ((const float*)(const GAS float*)karg_u64<8 * (i)>())
#define KA_OUT() ((float*)(GAS float*)karg_u64<96>())
#define KA_WS() ((unsigned char*)(GAS unsigned char*)karg_u64<104>())
struct Frame {
    LAS unsigned char* lds;
    unsigned char* ws;
    int lane, wave, gw, NGW;
};
__device__ __forceinline__ Frame make_frame(LAS unsigned char* lds, int wave_s) {
    Frame F; F.lds = lds; F.ws = KA_WS(); F.lane = lane_now(); F.wave = wave_s;
    F.gw = blockIdx.x * NWAVES + F.wave; F.NGW = NWG * NWAVES; return F;
}

struct TItem { f32x4 r[8]; f32x4 g[2]; };
__device__ __forceinline__ unsigned cvtpk_t(float lo, float hi) { typedef float f2_t __attribute__((ext_vector_type(2))); typedef __bf16 b2_t __attribute__((ext_vector_type(2))); f2_t v = {lo, hi}; b2_t b = __builtin_convertvector(v, b2_t); return __builtin_bit_cast(unsigned, b); }
__device__ __forceinline__ void titem_load(TItem& t, const float* W, int ldw, int c0, int k0, int lane, const float* gain) {
    const int kr = lane >> 3, c4 = lane & 7;
#pragma unroll
    for (int i = 0; i < 8; ++i) t.r[i] = __builtin_nontemporal_load((const GAS f32x4*)(W + (size_t)(k0 + 8 * kr + i) * ldw + c0 + 4 * c4));
    if (gain) { t.g[0] = *(const GAS f32x4*)(gain + k0 + 8 * kr); t.g[1] = *(const GAS f32x4*)(gain + k0 + 8 * kr + 4); }
}
__device__ __forceinline__ void titem_store(const TItem& t, int k0, bf16* WT, int K, int r0, LAS float* scr, int lane, bool has_gain) {
    const int kr = lane >> 3, c4 = lane & 7; (void)scr;
    GAS v4u* o = (GAS v4u*)(WT + (size_t)(r0 + 4 * c4) * K + k0 + 8 * kr);
#pragma unroll
    for (int e = 0; e < 4; ++e) {
        v4u w;
        if (has_gain) { w.x = cvtpk_t(t.r[0][e] * t.g[0].x, t.r[1][e] * t.g[0].y); w.y = cvtpk_t(t.r[2][e] * t.g[0].z, t.r[3][e] * t.g[0].w);
                        w.z = cvtpk_t(t.r[4][e] * t.g[1].x, t.r[5][e] * t.g[1].y); w.w = cvtpk_t(t.r[6][e] * t.g[1].z, t.r[7][e] * t.g[1].w); }
        else { w.x = cvtpk_t(t.r[0][e], t.r[1][e]); w.y = cvtpk_t(t.r[2][e], t.r[3][e]); w.z = cvtpk_t(t.r[4][e], t.r[5][e]); w.w = cvtpk_t(t.r[6][e], t.r[7][e]); }
        *(GAS v4u*)((GAS unsigned char*)o + (size_t)e * K * 2) = w; }
}
template <int NIF = 3>
__device__ __forceinline__ void transpose_seg(Frame& F, long& base, const float* W, int ldw, int K, int c0, int ncols, bf16* WT, int r0, LAS float* scr, const float* gain = nullptr) {
    const int nblk = ncols / 32, nit = (K / 64) * nblk;
    long first = ((long)__builtin_amdgcn_readfirstlane(F.gw) - base) % F.NGW; if (first < 0) first += F.NGW;
    TItem t[NIF]; const long st = F.NGW; long it[NIF];
#pragma unroll
    for (int q = 0; q < NIF; ++q) { it[q] = first + q * st; if (it[q] < nit) titem_load(t[q], W, ldw, c0 + 32 * (int)(it[q] % nblk), 64 * (int)(it[q] / nblk), F.lane, gain); }
    while (it[0] < nit) {
#pragma unroll
        for (int q = 0; q < NIF; ++q) if (it[q] < nit) {
            titem_store(t[q], 64 * (int)(it[q] / nblk), WT, K, r0 + 32 * (int)(it[q] % nblk), scr, F.lane, gain != nullptr); it[q] += NIF * st;
            if (it[q] < nit) titem_load(t[q], W, ldw, c0 + 32 * (int)(it[q] % nblk), 64 * (int)(it[q] / nblk), F.lane, gain); }
    }
    base += nit;
}
__device__ __forceinline__ void rms_row_to_f32(const float* xrow, const float* g, float* orow, int lane) {
    const GAS f32x4* xr = (const GAS f32x4*)xrow + lane; const GAS f32x4* gr = (const GAS f32x4*)g + lane;
    f32x4 v[16]; float s = 0.f;
#pragma unroll
    for (int j = 0; j < 16; ++j) { v[j] = __builtin_nontemporal_load(xr + 64 * j); s += (v[j].x * v[j].x + v[j].y * v[j].y) + (v[j].z * v[j].z + v[j].w * v[j].w); }
    const float rstd = 1.f / sqrtf(wave_sum(s) * (1.f / DM) + NORM_EPS);
    GAS f32x4* o = (GAS f32x4*)orow + lane;
#pragma unroll
    for (int j = 0; j < 16; ++j) { const f32x4 gg = gr[64 * j]; __builtin_nontemporal_store((v[j] * rstd) * gg, o + 64 * j); }
}

__host__ __device__ constexpr int inproj_gemm_wgs(int G) { const int nwg = (M / 256) * (NIN / 256), rounds = (nwg + G - 1) / G; return (nwg + rounds - 1) / rounds; }
__device__ __forceinline__ void side_convert(LAS unsigned char* lds, const int wave_s, int l, int rank, int H) {
    Frame F = make_frame(lds, wave_s); F.gw = rank * NWAVES + F.wave; F.NGW = H * NWAVES;
    LAS float* scr = (LAS float*)(F.lds + RING_OFF + F.wave * 16384);
    unsigned char* wl = F.ws + WS_W + (size_t)l * SZ_WLAYER; const float* g_mlp = KA_IN(8) + (size_t)l * DM; long base = 0;
    transpose_seg(F, base, KA_IN(7) + (size_t)l * MIXW * DM, DM, MIXW, 0, DM, (bf16*)(wl + OFF_WO), 0, scr);
    transpose_seg(F, base, KA_IN(9) + (size_t)l * DM * FF, FF, DM, 0, FF, (bf16*)(wl + OFF_WUP), 0, scr, g_mlp);
}
template <int NIF>
__device__ __forceinline__ void convert_front(Frame& F, long& base, int l) {
    unsigned char* wl = F.ws + WS_W + (size_t)l * SZ_WLAYER; LAS float* scr = nullptr;
    const float* w_in = KA_IN(2) + (size_t)l * DM * NIN_ORIG; const float* g_attn = KA_IN(1) + (size_t)l * DM;
    bf16* WinT = (bf16*)(wl + OFF_WIN);
    transpose_seg<NIF>(F, base, w_in, NIN_ORIG, DM, 0, O_CQ, WinT, 0, scr, g_attn);
    transpose_seg<NIF>(F, base, w_in, NIN_ORIG, DM, O_CQ, QL + KVL, WinT, C_CQ, scr, g_attn);
    transpose_seg<NIF>(F, base, w_in, NIN_ORIG, DM, O_KR, 64, WinT, C_KR, scr, g_attn);
    transpose_seg<NIF>(F, base, KA_IN(5) + (size_t)l * QL * NUQ, NUQ, QL, 0, NUQ, (bf16*)(wl + OFF_WUQ), 0, scr);
    transpose_seg<NIF>(F, base, KA_IN(6) + (size_t)l * KVL * NUKV, NUKV, KVL, 0, NUKV, (bf16*)(wl + OFF_WUKV), 0, scr);
    { unsigned z = 0u; asm volatile("" : "+v"(z));
      for (int i = F.gw * 64 + F.lane; i < 32 * DM * 2 / 16; i += F.NGW * 64) ((GAS v4u*)(WinT + (size_t)C_PAD * DM))[i] = (v4u){z, z, z, z}; }
}
constexpr int ATT_CONV = 128;
__device__ __forceinline__ void wdn_convert(LAS unsigned char* lds, const int wave_s, int l, int rank) {
    Frame F = make_frame(lds, wave_s); F.gw = rank * NWAVES + F.wave; F.NGW = ATT_CONV * NWAVES;
    unsigned char* wl = F.ws + WS_W + (size_t)l * SZ_WLAYER; long base = 0;
    transpose_seg<5>(F, base, KA_IN(10) + (size_t)l * FF * DM, DM, FF, 0, DM, (bf16*)(wl + OFF_WDN), 0, (LAS float*)nullptr);
    if (l + 1 < DEPTH) convert_front<5>(F, base, l + 1);
}
__device__ __forceinline__ void p0_prologue(LAS unsigned char* lds, const int wave_s) {
    Frame F = make_frame(lds, wave_s);
    LAS float* scr = (LAS float*)(F.lds + RING_OFF + F.wave * 16384);
    long base = 0;
    convert_front<3>(F, base, 0);
    {
        float2* tabA = (float2*)(F.ws + WS_TABA); float2* tabB = (float2*)(F.ws + WS_TABB);
        const int gt = F.gw * 64 + F.lane, NT = F.NGW * 64;
        for (int i = gt; i < T * 32; i += NT) { const int t = i >> 5, k = i & 31; const float inv = expf((-9.210340371976184f * (float)k) * (2.0f / 64.0f)); const float ang = (float)t * inv; tabA[i] = make_float2(cosf(ang), sinf(ang)); }
        for (int i = gt; i < T * 16; i += NT) { const int t = i >> 4, k = i & 15; const float inv = expf((-13.122363377404328f * (float)k) * (2.0f / 32.0f)); const float ang = (float)t * inv; tabB[i] = make_float2(cosf(ang), sinf(ang)); }
    }
    { const float* x = KA_IN(0); float* rss = (float*)(F.ws + WS_CTL) + CW_ROWSS;
      for (int m = F.gw; m < M; m += F.NGW) {
          const GAS f32x4* xr = (const GAS f32x4*)(x + (size_t)m * DM) + F.lane; GAS v2u* o8 = (GAS v2u*)((bf16*)(F.ws + WS_U) + (size_t)m * DM) + F.lane; float sq = 0.f;
#pragma unroll
          for (int j = 0; j < 16; ++j) { const f32x4 v = __builtin_nontemporal_load(xr + 64 * j); sq += (v.x * v.x + v.y * v.y) + (v.z * v.z + v.w * v.w); v2u o; o.x = pk2(v.x, v.y); o.y = pk2(v.z, v.w); o8[64 * j] = o; }
          sq = wave_sum(sq); if (F.lane == 0) rss[m] = sq; } }
}

__device__ __forceinline__ v4u rope_chunk(v4u own, v4u par, const float2* tab8, float sg, float scale) {
    const GAS f32x4* tp = (const GAS f32x4*)tab8; unsigned ow[4] = {own.x, own.y, own.z, own.w}, pw[4] = {par.x, par.y, par.z, par.w};
#pragma unroll
    for (int jj = 0; jj < 4; ++jj) { const f32x4 cs = tp[jj];
        ow[jj] = pk2((bflo(ow[jj]) * cs.x + sg * bflo(pw[jj]) * cs.y) * scale, (bfhi(ow[jj]) * cs.z + sg * bfhi(pw[jj]) * cs.w) * scale); }
    return (v4u){ow[0], ow[1], ow[2], ow[3]};
}
__device__ __forceinline__ void prep_phase(LAS unsigned char* lds, const int wave_s, int layer) {
    Frame F = make_frame(lds, wave_s);
    bf16* proj = (bf16*)(F.ws + WS_PROJ); bf16* cqn = (bf16*)(F.ws + WS_CQN); bf16* ckvn = (bf16*)(F.ws + WS_CKVN);
    const float2* tabA = (const float2*)(F.ws + WS_TABA); const float2* tabB = (const float2*)(F.ws + WS_TABB);
    const float* gq = KA_IN(3) + (size_t)layer * QL; const float* gkv = KA_IN(4) + (size_t)layer * KVL;
    const int lane = F.lane;
    for (int m = F.gw; m < M; m += F.NGW) {
        const int t = m & (T - 1), bb = m / T; bf16* row = proj + (size_t)m * NIN; const float2* ta = tabA + t * 32; const float2* tb = tabB + t * 16;
        GAS v4u* rq = (GAS v4u*)(row + C_RQ); GAS v4u* rk = (GAS v4u*)(row + C_RK); GAS v4u* kr = (GAS v4u*)(row + C_KR);
        const v4u rq_o = rq[lane], rq_p = rq[lane ^ 4], rk_o = rk[lane], rk_p = rk[lane ^ 4];
        const int dh = lane >> 2, dc = lane & 3;
        GAS v4u* dqp = (GAS v4u*)(row + C_DQ + (lane < 48 ? dh : 0) * 128);
        const v4u dq_o = dqp[dc], dq_p = dqp[dc ^ 2];
        GAS v4u* iq0 = (GAS v4u*)(row + C_IQ + dh * 128); GAS v4u* iq1 = (GAS v4u*)(row + C_IQ + (16 + dh) * 128);
        const v4u i0_o = iq0[dc], i0_p = iq0[dc ^ 2], i1_o = iq1[dc], i1_p = iq1[dc ^ 2];
        const v4u kr_o = kr[lane & 7], kr_p = kr[(lane & 7) ^ 4];
        const int n = lane >> 4, c = lane & 15;
        const GAS v4u* dks = (const GAS v4u*)(row + C_DK + n * 128); const GAS v4u* iks = (const GAS v4u*)(row + C_IK);
        v4u dk_o = dks[c]; const v4u dk_p = dks[c < 4 ? (c ^ 2) : c]; v4u ik_o = iks[c]; const v4u ik_p = iks[c < 4 ? (c ^ 2) : c];
        const v4u dv_o = ((const GAS v4u*)(row + C_DV + n * 128))[c];
        const GAS v4u* cqs = (const GAS v4u*)(row + C_CQ); const v4u cq0 = cqs[lane], cq1 = cqs[64 + (lane & 31)]; const v4u ckv0 = ((const GAS v4u*)(row + C_CKV))[lane & 31];
        { const int c8 = lane & 7; const float sg = (c8 < 4) ? -1.f : 1.f; const float2* tq = ta + (c8 & 3) * 8;
          rq[lane] = rope_chunk(rq_o, rq_p, tq, sg, 1.f); rk[lane] = rope_chunk(rk_o, rk_p, tq, sg, 0.125f);
          if (lane < 8) kr[lane] = rope_chunk(kr_o, kr_p, tq, sg, 1.f); }
        { const float sg = (dc < 2) ? -1.f : 1.f; const float2* tq = tb + (dc & 1) * 8;
          if (lane < 48) dqp[dc] = rope_chunk(dq_o, dq_p, tq, sg, 1.f);
          iq0[dc] = rope_chunk(i0_o, i0_p, tq, sg, 1.f); iq1[dc] = rope_chunk(i1_o, i1_p, tq, sg, 1.f); }
        { if (c < 4) { const float sg = (c < 2) ? -1.f : 1.f; const float2* tq = tb + (c & 1) * 8; dk_o = rope_chunk(dk_o, dk_p, tq, sg, 1.f); ik_o = rope_chunk(ik_o, ik_p, tq, sg, 1.f); }
          const size_t di = (((size_t)(bb * 4 + n)) * T + t) * 128 + c * 8;
          *(GAS v4u*)((bf16*)(F.ws + WS_DKC) + di) = dk_o;
          *(GAS v4u*)((bf16*)(F.ws + WS_DVC) + di) = dv_o;
          if (lane < 16) *(GAS v4u*)((bf16*)(F.ws + WS_IKC) + (size_t)m * 128 + c * 8) = ik_o; }
        { const unsigned w0[4] = {cq0.x, cq0.y, cq0.z, cq0.w}, w1[4] = {cq1.x, cq1.y, cq1.z, cq1.w}; float sq = 0.f, sq1 = 0.f;
#pragma unroll
          for (int jj = 0; jj < 4; ++jj) { sq += bflo(w0[jj]) * bflo(w0[jj]) + bfhi(w0[jj]) * bfhi(w0[jj]); sq1 += bflo(w1[jj]) * bflo(w1[jj]) + bfhi(w1[jj]) * bfhi(w1[jj]); }
          if (lane < 32) sq += sq1;
          const float rstd = 1.f / sqrtf(wave_sum(sq) * (1.f / QL) + NORM_EPS);
          { const GAS f32x4* gp = (const GAS f32x4*)(gq + 8 * lane); const f32x4 ga = gp[0], gb = gp[1]; v4u o;
            o.x = pk2(bflo(w0[0]) * rstd * ga.x, bfhi(w0[0]) * rstd * ga.y); o.y = pk2(bflo(w0[1]) * rstd * ga.z, bfhi(w0[1]) * rstd * ga.w);
            o.z = pk2(bflo(w0[2]) * rstd * gb.x, bfhi(w0[2]) * rstd * gb.y); o.w = pk2(bflo(w0[3]) * rstd * gb.z, bfhi(w0[3]) * rstd * gb.w);
            *(GAS v4u*)(cqn + (size_t)m * QL + 8 * lane) = o; }
          if (lane < 32) { const GAS f32x4* gp = (const GAS f32x4*)(gq + 512 + 8 * lane); const f32x4 ga = gp[0], gb = gp[1]; v4u o;
            o.x = pk2(bflo(w1[0]) * rstd * ga.x, bfhi(w1[0]) * rstd * ga.y); o.y = pk2(bflo(w1[1]) * rstd * ga.z, bfhi(w1[1]) * rstd * ga.w);
            o.z = pk2(bflo(w1[2]) * rstd * gb.x, bfhi(w1[2]) * rstd * gb.y); o.w = pk2(bflo(w1[3]) * rstd * gb.z, bfhi(w1[3]) * rstd * gb.w);
            *(GAS v4u*)(cqn + (size_t)m * QL + 512 + 8 * lane) = o; } }
        { const unsigned w0[4] = {ckv0.x, ckv0.y, ckv0.z, ckv0.w}; float sq = 0.f;
#pragma unroll
          for (int jj = 0; jj < 4; ++jj) sq += bflo(w0[jj]) * bflo(w0[jj]) + bfhi(w0[jj]) * bfhi(w0[jj]);
          if (lane >= 32) sq = 0.f;
          const float rstd = 1.f / sqrtf(wave_sum(sq) * (1.f / KVL) + NORM_EPS);
          if (lane < 32) { const GAS f32x4* gp = (const GAS f32x4*)(gkv + 8 * lane); const f32x4 ga = gp[0], gb = gp[1]; v4u o;
            o.x = pk2(bflo(w0[0]) * rstd * ga.x, bfhi(w0[0]) * rstd * ga.y); o.y = pk2(bflo(w0[1]) * rstd * ga.z, bfhi(w0[1]) * rstd * ga.w);
            o.z = pk2(bflo(w0[2]) * rstd * gb.x, bfhi(w0[2]) * rstd * gb.y); o.w = pk2(bflo(w0[3]) * rstd * gb.z, bfhi(w0[3]) * rstd * gb.w);
            *(GAS v4u*)(ckvn + (size_t)m * KVL + 8 * lane) = o; } }
    }
}


__device__ __forceinline__ unsigned sortable(float f) { const unsigned u = __builtin_bit_cast(unsigned, f); return (u & 0x80000000u) ? ~u : (u | 0x80000000u); }
typedef short bf16x8 __attribute__((ext_vector_type(8)));
typedef short s16x4 __attribute__((ext_vector_type(4)));
typedef short v4i16_t __attribute__((ext_vector_type(4)));
typedef float f32x16 __attribute__((ext_vector_type(16)));
typedef float f32x2_t __attribute__((ext_vector_type(2))); typedef __bf16 bf16x2_t __attribute__((ext_vector_type(2)));
__device__ __forceinline__ unsigned cvtpk_s(float lo, float hi) { f32x2_t v = {lo, hi}; bf16x2_t b = __builtin_convertvector(v, bf16x2_t); return __builtin_bit_cast(unsigned, b); }
#define MFMA32(a, b, c) __builtin_amdgcn_mfma_f32_32x32x16_bf16((a), (b), (c), 0, 0, 0)
__device__ __forceinline__ int crow(int r, int hi) { return (r & 3) + 8 * (r >> 2) + 4 * hi; }
__device__ __forceinline__ s16x4 vtr(const LAS char* p) { return __builtin_bit_cast(s16x4, __builtin_amdgcn_ds_read_tr16_b64_v4i16((LAS v4i16_t*)p)); }
__device__ __forceinline__ bf16x8 pack8f(float a0, float a1, float a2, float a3, float a4, float a5, float a6, float a7) {
    v4u w; w.x = cvtpk_s(a0, a1); w.y = cvtpk_s(a2, a3); w.z = cvtpk_s(a4, a5); w.w = cvtpk_s(a6, a7); return __builtin_bit_cast(bf16x8, w);
}
constexpr int CW_QUEUE = 8192;
__device__ __forceinline__ unsigned* queue_word(unsigned char* ws, int layer, int k) { return (unsigned*)(ws + WS_CTL) + CW_QUEUE + (layer * 32 + k) * 64; }

template <int MODE> struct AttnCfg;
template <> struct AttnCfg<0> { static constexpr int NKS = 12, KROW = 384, KPW = 3; };
template <> struct AttnCfg<1> { static constexpr int NKS = 4, KROW = 128, KPW = 1; };
template <> struct AttnCfg<2> { static constexpr int NKS = 4, KROW = 128, KPW = 1; };
template <int MODE>
__device__ __forceinline__ void attn_unit(LAS unsigned char* lds, unsigned char* ws, int b, int h, int qb, int tid) {
    typedef AttnCfg<MODE> C;
    const int lane = tid & 63, wave = __builtin_amdgcn_readfirstlane(tid >> 6), r32 = lane & 31, hh = lane >> 5;
    const bf16* proj = (const bf16*)(ws + WS_PROJ); const bf16* qm = (const bf16*)(ws + WS_QMLA); const bf16* kvm = (const bf16*)(ws + WS_KVMLA); bf16* mix = (bf16*)(ws + WS_MIX);
    const int q0w = 256 * qb + 32 * wave, qabs = q0w + r32; const size_t mrow = (size_t)b * T + qabs;
    bf16x8 qf[C::NKS];
    if (MODE == 0) {
        const GAS v4u* qp = (const GAS v4u*)(qm + mrow * NUQ + h * 192);
        v4u raw[12];
#pragma unroll
        for (int ks = 0; ks < 12; ++ks) raw[ks] = qp[2 * ks + hh];
        unsigned char* wsl = ws; asm volatile("" : "+s"(wsl));
        const GAS f32x4* tp = (const GAS f32x4*)((const float2*)(wsl + WS_TABA) + qabs * 32);
#pragma unroll
        for (int ks = 8; ks < 10; ++ks) {
            unsigned x1w[4] = {raw[ks].x, raw[ks].y, raw[ks].z, raw[ks].w}, x2w[4] = {raw[ks + 2].x, raw[ks + 2].y, raw[ks + 2].z, raw[ks + 2].w};
            unsigned y1w[4], y2w[4];
#pragma unroll
            for (int jj = 0; jj < 4; ++jj) {
                const f32x4 cs = tp[(16 * (ks - 8) + 8 * hh) / 2 + jj];
                const float a1 = bflo(x1w[jj]), a2 = bflo(x2w[jj]), b1 = bfhi(x1w[jj]), b2 = bfhi(x2w[jj]);
                y1w[jj] = cvtpk_s(a1 * cs.x - a2 * cs.y, b1 * cs.z - b2 * cs.w);
                y2w[jj] = cvtpk_s(a2 * cs.x + a1 * cs.y, b2 * cs.z + b1 * cs.w);
            }
            raw[ks] = (v4u){y1w[0], y1w[1], y1w[2], y1w[3]}; raw[ks + 2] = (v4u){y2w[0], y2w[1], y2w[2], y2w[3]};
        }
#pragma unroll
        for (int ks = 0; ks < 12; ++ks) qf[ks] = __builtin_bit_cast(bf16x8, raw[ks]);
    } else if (MODE == 1) {
        const GAS v4u* qp = (const GAS v4u*)(proj + mrow * NIN + C_RQ + h * 64);
#pragma unroll
        for (int ks = 0; ks < C::NKS; ++ks) qf[ks] = __builtin_bit_cast(bf16x8, qp[2 * ks + hh]);
    } else {
        const int dsel = 32 * wave + r32;
#pragma unroll
        for (int ks = 0; ks < C::NKS; ++ks)
#pragma unroll
            for (int jj = 0; jj < 8; ++jj) qf[ks][jj] = (wave < 2 && 16 * ks + 8 * hh + jj == dsel) ? (short)0x3F80 : (short)0;
    }
    constexpr int KBYTES = 64 * C::KROW, BUFSZ = KBYTES + 16384;
    const size_t brow = (size_t)b * T;
    unsigned koffA[C::KPW]; bool kisA[C::KPW]; unsigned voffs[2];
#pragma unroll
    for (int i = 0; i < C::KPW; ++i) { const int o = (wave + 8 * i) * 1024 + lane * 16, row = o / C::KROW, pos = (o % C::KROW) / 16, c = (pos & ~7) | ((pos & 7) ^ ((row >> 1) & 7));
        if (MODE == 0) { kisA[i] = c < 16; koffA[i] = kisA[i] ? (unsigned)(row * 512 + c * 16) : (unsigned)(row * (NIN * 2) + (c - 16) * 16); }
        else { kisA[i] = true; koffA[i] = (unsigned)(row * (NIN * 2) + c * 16); } }
#pragma unroll
    for (int i = 0; i < 2; ++i) { const int row = 4 * (wave + 8 * i) + (lane >> 4), c = (lane & 15) ^ (4 * (row & 3)); voffs[i] = (unsigned)(row * (MODE == 0 ? 512 : NIN * 2) + c * 16); }
    const char* kbaseA = (MODE == 0) ? (const char*)(kvm + ((size_t)h * M + brow) * 256) : (const char*)(proj + brow * NIN + C_RK + h * 64);
    const char* kbaseB = (const char*)(proj + brow * NIN + C_KR);
    const char* vbase_ = (MODE == 0) ? (const char*)(kvm + ((size_t)h * M + brow) * 256 + 128) : (const char*)(proj + brow * NIN + C_RV + h * 128);
    auto issue = [&](int j, int boff) {
        const size_t stepA = (size_t)j * 64 * (MODE == 0 ? 512 : NIN * 2), stepB = (size_t)j * 64 * (NIN * 2);
#pragma unroll
        for (int i = 0; i < C::KPW; ++i) { const char* p = kisA[i] ? (kbaseA + stepA + koffA[i]) : (kbaseB + stepB + koffA[i]);
            __builtin_amdgcn_global_load_lds((const GAS unsigned*)p, (LAS unsigned*)(lds + boff + (wave + 8 * i) * 1024), 16, 0, 0); }
#pragma unroll
        for (int i = 0; i < 2; ++i) __builtin_amdgcn_global_load_lds((const GAS unsigned*)(vbase_ + stepA + voffs[i]), (LAS unsigned*)(lds + boff + KBYTES + (wave + 8 * i) * 1024), 16, 0, 0);
    };
    f32x16 o[4];
#pragma unroll
    for (int d = 0; d < 4; ++d)
#pragma unroll
        for (int i = 0; i < 16; ++i) o[d][i] = 0.f;
    float mrun = -1e30f, lrun = 0.f;
    constexpr float C2 = 0.07216878364870322f * 1.4426950408889634f;
    const float lg2 = (MODE != 0) ? log1pf(-exp2f(-5.f - (float)h)) * 1.4426950408889634f : 0.f;
    const int ntiles = 4 * (qb + 1), jlo = (MODE == 0) ? 0 : 4 * qb;
    const int trq = (lane & 15) >> 2, trp = lane & 3, trb = (lane >> 4) & 1;
    const int voff = (4 * hh + trq) * 256 + (2 * trb + (trp >> 1)) * 16 + (trp & 1) * 8;
    const int kt0 = hh ^ ((r32 >> 1) & 7);
    constexpr int ST_OFF = 3 * BUFSZ;
    if (MODE == 1 && qb > 0) {
        const int sd = tid >> 3, se = (tid & 7) * 16; float sa[16];
#pragma unroll
        for (int i = 0; i < 16; ++i) sa[i] = 0.f;
        const float* bu = (const float*)(ws + WS_BU) + ((size_t)((b * 8 + h) * 16) * 64 + sd) * 128 + se;
#pragma unroll 4
        for (int up = 0; up < qb; ++up) { const float wgt = __builtin_amdgcn_exp2f((float)(256 * (qb - 1 - up)) * lg2); const GAS f32x4* p4 = (const GAS f32x4*)(bu + (size_t)up * 64 * 128);
#pragma unroll
            for (int i = 0; i < 4; ++i) { const f32x4 v = p4[i]; sa[4 * i] = fmaf(wgt, v.x, sa[4 * i]); sa[4 * i + 1] = fmaf(wgt, v.y, sa[4 * i + 1]); sa[4 * i + 2] = fmaf(wgt, v.z, sa[4 * i + 2]); sa[4 * i + 3] = fmaf(wgt, v.w, sa[4 * i + 3]); } }
        LAS unsigned char* st = lds + ST_OFF + sd * 256; const int c0 = (tid & 7) * 2, sw = 4 * (sd & 3);
        *(LAS v4u*)(st + ((c0 ^ sw) << 4)) = (v4u){cvtpk_s(sa[0], sa[1]), cvtpk_s(sa[2], sa[3]), cvtpk_s(sa[4], sa[5]), cvtpk_s(sa[6], sa[7])};
        *(LAS v4u*)(st + (((c0 + 1) ^ sw) << 4)) = (v4u){cvtpk_s(sa[8], sa[9]), cvtpk_s(sa[10], sa[11]), cvtpk_s(sa[12], sa[13]), cvtpk_s(sa[14], sa[15])};
    }
    int b_cur = 0, b_nxt = BUFSZ, b_nn = 2 * BUFSZ;
    issue(jlo, b_cur); if (jlo + 1 < ntiles) issue(jlo + 1, b_nxt);
    constexpr int PW = C::KPW + 2;
    for (int j = jlo; j < ntiles; ++j) {
        if (j + 1 < ntiles) { if (PW == 5) asm volatile("s_waitcnt vmcnt(5) lgkmcnt(0)\n\ts_barrier" ::: "memory"); else asm volatile("s_waitcnt vmcnt(3) lgkmcnt(0)\n\ts_barrier" ::: "memory"); }
        else asm volatile("s_waitcnt vmcnt(0) lgkmcnt(0)\n\ts_barrier" ::: "memory");
        if (j + 2 < ntiles) issue(j + 2, b_nn);
        if ((MODE == 2) ? (wave < 2) : (64 * j <= q0w + 31)) {
            const LAS unsigned char* kb = lds + b_cur + r32 * C::KROW;
            const LAS unsigned char* vb = lds + b_cur + KBYTES + voff;
            f32x16 s0, s1;
#pragma unroll
            for (int i = 0; i < 16; ++i) { s0[i] = 0.f; s1[i] = 0.f; }
            { bf16x8 kfa[3], kfb[3];
#define AT_KREAD(ks_, sl_) do { const int kco_ = (((2 * (ks_)) & ~7) << 4) | ((((2 * (ks_)) & 7) ^ kt0) << 4); kfa[sl_] = *(const LAS bf16x8*)(kb + kco_); kfb[sl_] = *(const LAS bf16x8*)(kb + 32 * C::KROW + kco_); } while (0)
              AT_KREAD(0, 0); AT_KREAD(1, 1);
              __builtin_amdgcn_sched_barrier(0);
#pragma unroll
              for (int ks = 0; ks < C::NKS; ++ks) {
                  if (ks + 2 < C::NKS) AT_KREAD(ks + 2, (ks + 2) % 3);
                  s0 = MFMA32(kfa[ks % 3], qf[ks], s0); s1 = MFMA32(kfb[ks % 3], qf[ks], s1);
                  __builtin_amdgcn_sched_barrier(0);
              }
#undef AT_KREAD
            }
            const int dq = qabs - 64 * j - 4 * hh;
            bf16x8 pf[4];
            if (MODE == 0) {
                if (64 * j + 63 > q0w) {
#pragma unroll
                    for (int i = 0; i < 16; ++i) { const int c = (i & 3) + 8 * (i >> 2); if (c > dq) s0[i] = -__builtin_inff(); if (c + 32 > dq) s1[i] = -__builtin_inff(); }
                }
                float tmax = s0[0];
#pragma unroll
                for (int i = 1; i < 16; ++i) tmax = fmaxf(tmax, s0[i]);
#pragma unroll
                for (int i = 0; i < 16; ++i) tmax = fmaxf(tmax, s1[i]);
                tmax = fmaxf(tmax, __shfl_xor(tmax, 32));
                const float mnew = fmaxf(mrun, tmax); const float alpha = __builtin_amdgcn_exp2f((mrun - mnew) * C2); const bool grew = __builtin_amdgcn_ballot_w64(mnew > mrun) != 0ull; mrun = mnew;
                const float mc = -mnew * C2; float ps = 0.f;
#pragma unroll
                for (int i = 0; i < 16; ++i) { s0[i] = __builtin_amdgcn_exp2f(fmaf(s0[i], C2, mc)); s1[i] = __builtin_amdgcn_exp2f(fmaf(s1[i], C2, mc)); ps += s0[i] + s1[i]; }
                lrun = lrun * alpha + ps;
                if (grew) {
#pragma unroll
                for (int d = 0; d < 4; ++d)
#pragma unroll
                    for (int i = 0; i < 16; ++i) o[d][i] *= alpha; }
            } else {
                const int dqq = (MODE == 2) ? (256 * qb + 255 - 64 * j - 4 * hh) : dq;
#pragma unroll
                for (int i = 0; i < 16; ++i) { const int c = (i & 3) + 8 * (i >> 2);
                    const float w0 = (c <= dqq) ? __builtin_amdgcn_exp2f((float)(dqq - c) * lg2) : 0.f, w1 = (c + 32 <= dqq) ? __builtin_amdgcn_exp2f((float)(dqq - c - 32) * lg2) : 0.f;
                    s0[i] *= w0; s1[i] *= w1; }
            }
            pf[0] = pack8f(s0[0], s0[1], s0[2], s0[3], s0[4], s0[5], s0[6], s0[7]); pf[1] = pack8f(s0[8], s0[9], s0[10], s0[11], s0[12], s0[13], s0[14], s0[15]);
            pf[2] = pack8f(s1[0], s1[1], s1[2], s1[3], s1[4], s1[5], s1[6], s1[7]); pf[3] = pack8f(s1[8], s1[9], s1[10], s1[11], s1[12], s1[13], s1[14], s1[15]);
            { bf16x8 vfr[3];
#define AT_VREAD(ix_, sl_) do { const int s_ = (ix_) >> 2, d_ = (ix_) & 3; const s16x4 lo_ = vtr((const LAS char*)(vb + (16 * s_) * 256 + ((d_ ^ trq) << 6))), hi_ = vtr((const LAS char*)(vb + (16 * s_ + 8) * 256 + ((d_ ^ trq) << 6))); \
                                vfr[sl_] = __builtin_shufflevector(lo_, hi_, 0, 1, 2, 3, 4, 5, 6, 7); } while (0)
              AT_VREAD(0, 0); AT_VREAD(1, 1);
              __builtin_amdgcn_sched_barrier(0);
#pragma unroll
              for (int ix = 0; ix < 16; ++ix) {
                  if (ix + 2 < 16) AT_VREAD(ix + 2, (ix + 2) % 3);
                  o[ix & 3] = MFMA32(vfr[ix % 3], pf[ix >> 2], o[ix & 3]);
                  __builtin_amdgcn_sched_barrier(0);
              }
#undef AT_VREAD
            }
        }
        { const int t_ = b_cur; b_cur = b_nxt; b_nxt = b_nn; b_nn = t_; }
    }
    if (MODE == 1 && qb > 0) {
        const float dqv = __builtin_amdgcn_exp2f((float)(qabs - 256 * qb + 1) * lg2);
        const bf16* qrow = proj + mrow * NIN + C_RQ + h * 64 + 4 * hh;
        const LAS unsigned char* sb = lds + ST_OFF + voff;
#pragma unroll
        for (int s = 0; s < 4; ++s) {
            const v2u qlo = *(const GAS v2u*)(qrow + 16 * s), qhi = *(const GAS v2u*)(qrow + 16 * s + 8);
            const bf16x8 pq = pack8f(bflo(qlo.x) * dqv, bfhi(qlo.x) * dqv, bflo(qlo.y) * dqv, bfhi(qlo.y) * dqv, bflo(qhi.x) * dqv, bfhi(qhi.x) * dqv, bflo(qhi.y) * dqv, bfhi(qhi.y) * dqv);
#pragma unroll
            for (int d = 0; d < 4; ++d) {
                const s16x4 lo = vtr((const LAS char*)(sb + (16 * s) * 256 + ((d ^ trq) << 6))), hi = vtr((const LAS char*)(sb + (16 * s + 8) * 256 + ((d ^ trq) << 6)));
                const bf16x8 vf = __builtin_shufflevector(lo, hi, 0, 1, 2, 3, 4, 5, 6, 7);
                o[d] = MFMA32(vf, pq, o[d]);
            }
        }
    }
    if (MODE == 2) {
        if (wave < 2) { float* bo = (float*)(ws + WS_BU) + ((size_t)(((b * 8 + h) * 16 + qb) * 64 + 32 * wave + r32)) * 128 + 4 * hh;
#pragma unroll
            for (int d = 0; d < 4; ++d)
#pragma unroll
                for (int g = 0; g < 4; ++g) *(GAS f32x4*)(bo + 32 * d + 8 * g) = (f32x4){o[d][4 * g], o[d][4 * g + 1], o[d][4 * g + 2], o[d][4 * g + 3]}; }
        return;
    }
    if (MODE == 0) {
        const float lt = lrun + __shfl_xor(lrun, 32); const float il = 1.f / lt;
        bf16* orow = mix + mrow * MIXW + MIX_MLA + h * 128 + 4 * hh;
#pragma unroll
        for (int d = 0; d < 4; ++d)
#pragma unroll
            for (int g = 0; g < 4; ++g) { v2u w; w.x = cvtpk_s(o[d][4 * g] * il, o[d][4 * g + 1] * il); w.y = cvtpk_s(o[d][4 * g + 2] * il, o[d][4 * g + 3] * il);
                *(GAS v2u*)(orow + 32 * d + 8 * g) = w; }
    } else {
        float ss = 0.f;
#pragma unroll
        for (int d = 0; d < 4; ++d)
#pragma unroll
            for (int i = 0; i < 16; ++i) ss += o[d][i] * o[d][i];
        ss += __shfl_xor(ss, 32);
        const float rstd = 1.f / sqrtf(ss * (1.f / 128.f) + NORM_EPS);
        const bf16* grow = proj + mrow * NIN + C_RG + h * 128 + 4 * hh; bf16* orow = mix + mrow * MIXW + MIX_RET + h * 128 + 4 * hh;
#pragma unroll
        for (int d = 0; d < 4; ++d)
#pragma unroll
            for (int g = 0; g < 4; ++g) { const v2u gw = *(const GAS v2u*)(grow + 32 * d + 8 * g);
                const float g0 = bflo(gw.x), g1 = bfhi(gw.x), g2 = bflo(gw.y), g3 = bfhi(gw.y);
                const float y0 = (g0 / (1.f + __expf(-g0))) * (o[d][4 * g] * rstd), y1 = (g1 / (1.f + __expf(-g1))) * (o[d][4 * g + 1] * rstd);
                const float y2 = (g2 / (1.f + __expf(-g2))) * (o[d][4 * g + 2] * rstd), y3 = (g3 / (1.f + __expf(-g3))) * (o[d][4 * g + 3] * rstd);
                v2u w; w.x = cvtpk_s(y0, y1); w.y = cvtpk_s(y2, y3); *(GAS v2u*)(orow + 32 * d + 8 * g) = w; }
    }
}
template <int MODE> __device__ __forceinline__ void attn_phase(LAS unsigned char* lds, const int wave_s, int layer, int qk = 0) {
    constexpr int NH = (MODE == 0) ? 12 : 8, NU = BATCH * NH * 16;
    unsigned char* ws = KA_WS(); const int tid = tid_now(wave_s);
    unsigned* ctr = queue_word(ws, layer, MODE + qk);
    volatile LAS unsigned* uw = (volatile LAS unsigned*)(lds + LDSCTL_OFF);
    for (;;) {
        __syncthreads();
        if (tid == 0) uw[0] = __hip_atomic_fetch_add(ctr, 1u, __ATOMIC_RELAXED, __HIP_MEMORY_SCOPE_AGENT);
        __syncthreads();
        const unsigned u = uw[0];
        if (u >= (unsigned)NU) break;
        const int qb = 15 - (int)(u / (BATCH * NH)), bh = (int)(u % (BATCH * NH));
        attn_unit<MODE>(lds, ws, bh / NH, bh % NH, qb, tid);
    }
}

__device__ __forceinline__ float relu_i(float x) { const int i = __builtin_bit_cast(int, x); return __builtin_bit_cast(float, i > 0 ? i : 0); }
__device__ __forceinline__ void indexer_mfma(LAS unsigned char* lds, const int wave_s) {
    Frame F = make_frame(lds, wave_s);
    const bf16* proj = (const bf16*)(F.ws + WS_PROJ); int* sel = (int*)(F.ws + WS_SEL); float* isc = (float*)(F.ws + WS_ISC);
    const int lane = F.lane, r32 = lane & 31, hh = lane >> 5;
    for (int vw = blockIdx.x; vw < 256; vw += NWG)
    for (int it = 0; it < 2; ++it) {
        const int b = vw >> 7; const int jq = it ? (255 - (vw & 127)) : (vw & 127); const int t0 = 16 * jq, tA = t0 + 2 * F.wave; const size_t mA = (size_t)b * T + tA;
        if (t0 + 15 < TOPK) {
            for (int j = lane; j <= tA; j += 64) sel[mA * TOPK + j] = j;
            for (int j = lane; j <= tA + 1; j += 64) sel[(mA + 1) * TOPK + j] = j;
            continue; }
        bf16x8 afA[8], afB[8];
        { const GAS v4u* qp = (const GAS v4u*)(proj + mA * NIN + C_IQ + r32 * 128); const GAS v4u* qp2 = (const GAS v4u*)(proj + (mA + 1) * NIN + C_IQ + r32 * 128);
#pragma unroll
          for (int ks = 0; ks < 8; ++ks) { afA[ks] = __builtin_bit_cast(bf16x8, qp[2 * ks + hh]); afB[ks] = __builtin_bit_cast(bf16x8, qp2[2 * ks + hh]); } }
        float wvA[16], wvB[16];
#pragma unroll
        for (int r = 0; r < 16; ++r) { wvA[r] = bf2f(proj[mA * NIN + C_IW + crow(r, hh)]) * (0.17677669529663687f * 0.08838834764831845f);
                                       wvB[r] = bf2f(proj[(mA + 1) * NIN + C_IW + crow(r, hh)]) * (0.17677669529663687f * 0.08838834764831845f); }
        float* srowA = isc + mA * T; float* srowB = srowA + T;
        const int nch = (t0 + 15) / 256 + 1;
        const char* ikb = (const char*)(F.ws + WS_IKC) + (size_t)b * T * 256;
        const unsigned lane_off = (unsigned)((lane >> 4) * 256 + (((lane & 15) ^ ((4 * (F.wave & 3) + (lane >> 4)) & 15)) << 4));
        auto issue = [&](int c, int i0, int n) {
            LAS unsigned char* dst = F.lds + (c & 1) * 65536; int cc = c; asm volatile("" : "+s"(cc)); unsigned lo_ = lane_off; asm volatile("" : "+v"(lo_));
            for (int i = i0; i < i0 + n; ++i) { const int pi = F.wave + 8 * i; const unsigned off = lo_ + (unsigned)((cc * 256 + 4 * pi) * 256);
                __builtin_amdgcn_global_load_lds((const GAS unsigned*)(ikb + off), (LAS unsigned*)(dst + pi * 1024), 16, 0, 0); }
        };
        __syncthreads();
        issue(0, 0, 8);
        f32x16 a0, b0, a1, b1;
#pragma unroll
        for (int i = 0; i < 16; ++i) { a1[i] = 0.f; b1[i] = 0.f; }
        float xa0 = 0.f, xb0 = 0.f; int sprev = -1;
        for (int c = 0; c < nch; ++c) {
            if (c == 0) VM_WAIT(); else asm volatile("s_waitcnt vmcnt(4)" ::: "memory");
            __syncthreads();
            const bool more = c + 1 < nch;
            const LAS unsigned char* kb = F.lds + (c & 1) * 65536 + r32 * 256;
#pragma unroll 1
            for (int pp = 0; pp < 4; ++pp) {
                const int s0 = c * 256 + pp * 64; if (s0 > tA + 1) break;
                int ll = lane & 15; asm volatile("" : "+v"(ll));
                const LAS unsigned char* kbp = kb + (pp * 64) * 256;
                if (more && pp < 2) issue(c + 1, pp * 4, 2);
                __builtin_amdgcn_sched_barrier(0);
#pragma unroll
                for (int i = 0; i < 16; ++i) { a0[i] = 0.f; b0[i] = 0.f; }
                float xa1 = 0.f, xb1 = 0.f;
#pragma unroll
                for (int ks = 0; ks < 8; ++ks) { const bf16x8 bk = *(const LAS bf16x8*)(kbp + (((2 * ks + hh) ^ ll) << 4)); a0 = MFMA32(afA[ks], bk, a0); b0 = MFMA32(afB[ks], bk, b0); }
#pragma unroll
                for (int r = 0; r < 16; ++r) { xa1 = fmaf(wvA[r], relu_i(a1[r]), xa1); xb1 = fmaf(wvB[r], relu_i(b1[r]), xb1); }
#pragma unroll
                for (int i = 0; i < 16; ++i) { __builtin_amdgcn_sched_group_barrier(0x008, 1, 0); __builtin_amdgcn_sched_group_barrier(0x002, 4, 0); }
                __builtin_amdgcn_sched_barrier(0);
                asm volatile("" : "+v"(xa1), "+v"(xb1));
                if (sprev >= 0) {
                    const float ta0 = xa0 + __shfl_xor(xa0, 32), ta1 = xa1 + __shfl_xor(xa1, 32), tb0 = xb0 + __shfl_xor(xb0, 32), tb1 = xb1 + __shfl_xor(xb1, 32);
                    srowA[sprev + lane] = hh ? ta1 : ta0;
                    srowB[sprev + lane] = hh ? tb1 : tb0; }
                if (more && pp < 2) issue(c + 1, pp * 4 + 2, 2);
                __builtin_amdgcn_sched_barrier(0);
#pragma unroll
                for (int i = 0; i < 16; ++i) { a1[i] = 0.f; b1[i] = 0.f; }
                xa0 = 0.f; xb0 = 0.f;
#pragma unroll
                for (int ks = 0; ks < 8; ++ks) { const bf16x8 bk = *(const LAS bf16x8*)(kbp + 32 * 256 + (((2 * ks + hh) ^ ll) << 4)); a1 = MFMA32(afA[ks], bk, a1); b1 = MFMA32(afB[ks], bk, b1); }
#pragma unroll
                for (int r = 0; r < 16; ++r) { xa0 = fmaf(wvA[r], relu_i(a0[r]), xa0); xb0 = fmaf(wvB[r], relu_i(b0[r]), xb0); }
#pragma unroll
                for (int i = 0; i < 16; ++i) { __builtin_amdgcn_sched_group_barrier(0x008, 1, 0); __builtin_amdgcn_sched_group_barrier(0x002, 4, 0); }
                __builtin_amdgcn_sched_barrier(0);
                sprev = s0;
            }
        }
        { float xa1 = 0.f, xb1 = 0.f;
#pragma unroll
          for (int r = 0; r < 16; ++r) { xa1 = fmaf(wvA[r], relu_i(a1[r]), xa1); xb1 = fmaf(wvB[r], relu_i(b1[r]), xb1); }
          const float ta0 = xa0 + __shfl_xor(xa0, 32), ta1 = xa1 + __shfl_xor(xa1, 32), tb0 = xb0 + __shfl_xor(xb0, 32), tb1 = xb1 + __shfl_xor(xb1, 32);
          srowA[sprev + lane] = hh ? ta1 : ta0;
          srowB[sprev + lane] = hh ? tb1 : tb0; }
        VM_WAIT(); asm volatile("" ::: "memory");
        int lane2 = lane; asm volatile("" : "+v"(lane2));
#pragma unroll 1
        for (int qq = 0; qq < 2; ++qq) {
            const int t = tA + qq; const size_t m = mA + qq;
            unsigned u[64]; float s1 = 0.f, s2 = 0.f;
            { const float* sp = (qq ? srowB : srowA) + lane2;
#pragma unroll
              for (int g = 0; g < 64; ++g) { const float v = sp[g * 64]; const bool ok = (g * 64 + lane2 <= t); u[g] = ok ? sortable(v) : 0u;
                                             if ((g & 3) == 0) { const float vm = ok ? v : 0.f; s1 += vm; s2 = fmaf(vm, vm, s2); } } }
            s1 = wave_sum(s1); s2 = wave_sum(s2);
            float candf, dens;
            { const int nf = (t + 1 - 64) / 256 + 1, nfc = nf > 16 ? 16 : nf; int part = t + 1 - 256 * nfc; part = part < 0 ? 0 : (part > 64 ? 64 : part); const float ns = (float)(64 * nfc + (nfc < 16 ? part : 0));
              const float mu = s1 / ns, var = fmaxf(s2 / ns - mu * mu, 1e-30f), sd = sqrtf(var);
              const float n = (float)(t + 1), p = (float)TOPK / n, pm = fminf(p, 1.f - p);
              const float tt = sqrtf(-2.f * __logf(pm)); float z = tt - (2.30753f + 0.27061f * tt) / (1.f + tt * (0.99229f + 0.04481f * tt)); if (p > 0.5f) z = -z;
              dens = fmaxf(n * 0.3989423f * __expf(-0.5f * z * z) / sd, 1e-20f); candf = mu + z * sd; }
            unsigned lo_u = 1u, hi_u = 0xFFFFFFFFu, thr = 1u, cl = 0u; float lo_f = 0.f, hi_f = 0.f; int cnt_lo = 0, cnt_hi = 0; bool lo_ok = false, hi_ok = false, exact = false;
            for (int it = 0; ; ++it) {
                if (hi_u - lo_u <= 1u) { thr = lo_u; break; }
                unsigned cu = sortable(candf);
                if (it >= 12 || !(cu > lo_u && cu < hi_u)) cu = lo_u + ((hi_u - lo_u) >> 1);
                cl = 0u;
#pragma unroll
                for (int g = 0; g < 64; ++g) cl += (u[g] >= cu) ? 1u : 0u;
                int cnt = 0;
#pragma unroll
                for (int k = 0; k < 7; ++k) cnt += __popcll(__ballot((cl >> k) & 1u)) << k;
                if (cnt == TOPK) { thr = cu; exact = true; break; }
                const float cf = __builtin_bit_cast(float, (cu & 0x80000000u) ? (cu & 0x7fffffffu) : ~cu);
                if (cnt > TOPK) { lo_u = cu; lo_f = cf; cnt_lo = cnt; lo_ok = true; } else { hi_u = cu; hi_f = cf; cnt_hi = cnt; hi_ok = true; }
                if (lo_ok && hi_ok) candf = lo_f + (hi_f - lo_f) * (((float)cnt_lo - 255.5f) / (float)(cnt_lo - cnt_hi));
                else { candf = cf + ((float)cnt - 255.5f) / dens; dens *= 0.5f; }
            }
            if (exact) {
                int pre = 0; const unsigned long long ltm = (1ull << lane2) - 1ull;
#pragma unroll
                for (int k = 0; k < 7; ++k) pre += __popcll(__ballot((cl >> k) & 1u) & ltm) << k;
                int* sp2 = sel + m * TOPK + pre;
#pragma unroll
                for (int g = 0; g < 64; ++g) { if (u[g] >= thr) { *sp2 = g * 64 + lane2; ++sp2; } }
            } else {
            int cgt = 0;
            { unsigned cl2 = 0u;
#pragma unroll
              for (int g = 0; g < 64; ++g) cl2 += (u[g] > thr) ? 1u : 0u;
#pragma unroll
              for (int k = 0; k < 7; ++k) cgt += __popcll(__ballot((cl2 >> k) & 1u)) << k; }
            const int need_eq = TOPK - cgt; int base = 0, eq_seen = 0;
            const unsigned long long ltmask = (1ull << lane2) - 1ull;
#pragma unroll
            for (int g = 0; g < 64; ++g) {
                const bool gt = u[g] > thr, eq = u[g] == thr;
                const unsigned long long meq = __ballot(eq);
                const bool take = gt || (eq && (eq_seen + __popcll(meq & ltmask)) < need_eq);
                const unsigned long long ms = __ballot(take);
                if (take) sel[m * TOPK + base + __popcll(ms & ltmask)] = g * 64 + lane2;
                base += __popcll(ms); eq_seen += __popcll(meq);
            }
            }
            asm volatile("" ::: "memory");
        }
    }
}

#define MFMA16(a, b, c) __builtin_amdgcn_mfma_f32_16x16x32_bf16((a), (b), (c), 0, 0, 0)
#define SCHED_FENCE() __builtin_amdgcn_sched_barrier(0)
__device__ __forceinline__ void dsa_fast(LAS unsigned char* lds, const int wave_s, int layer, int qk = 0) {
    Frame F = make_frame(lds, wave_s);
    const bf16* proj = (const bf16*)(F.ws + WS_PROJ); const int* sel = (const int*)(F.ws + WS_SEL); bf16* mix = (bf16*)(F.ws + WS_MIX);
    LAS unsigned char* vring = F.lds + RING_OFF + F.wave * 16384;
    LAS unsigned char* xtra = F.lds + XTRA_OFF + F.wave * XTRA_WAVE;
    LAS unsigned short* il = (LAS unsigned short*)xtra;
    LAS float* sl = (LAS float*)(xtra + 512);
    volatile LAS unsigned* uw = (volatile LAS unsigned*)(F.lds + LDSCTL_OFF);
    const int lane = F.lane, c16 = lane & 15, kq = lane >> 4; const int tid = F.wave * 64 + lane;
    constexpr float C2 = 0.08838834764831845f * 1.4426950408889634f;
    const unsigned koff = (unsigned)(((lane & 15) ^ (lane >> 4)) << 4);
    const unsigned voff0 = (unsigned)(((lane & 15) ^ (2 * (lane >> 4))) << 4), voff1 = voff0 ^ 128u;
    const int trq = (lane & 15) >> 2, trp = lane & 3;
    int combo = (int)(xb_xcc_id() & 7u), tries = 0;
    bf16x8 ones;
#pragma unroll
    for (int j = 0; j < 8; ++j) ones[j] = (short)0x3F80;
    unsigned pend = 0u;
    if (tid == 0) pend = __hip_atomic_fetch_add(queue_word(F.ws, layer, 8 + combo + qk), 1u, __ATOMIC_RELAXED, __HIP_MEMORY_SCOPE_AGENT);
    for (int itn = 0;; ++itn) {
        if (tid == 0) {
            unsigned u = 0xffffffffu, v = pend;
            for (;;) { if (v < 512u) { u = (unsigned)combo * 512u + v; break; } combo = (combo + 1) & 7; if (++tries >= 8) break;
                v = __hip_atomic_fetch_add(queue_word(F.ws, layer, 8 + combo + qk), 1u, __ATOMIC_RELAXED, __HIP_MEMORY_SCOPE_AGENT); }
            uw[itn & 1] = u;
            if (u != 0xffffffffu) pend = __hip_atomic_fetch_add(queue_word(F.ws, layer, 8 + combo + qk), 1u, __ATOMIC_RELAXED, __HIP_MEMORY_SCOPE_AGENT);
        }
        __syncthreads();
        const unsigned u = uw[itn & 1];
        if (u == 0xffffffffu) break;
        const int cb = (int)(u >> 9), b = cb >> 2, n = cb & 3, t = (int)(u & 511u) * 8 + F.wave; const size_t m = (size_t)b * T + t; const int nsel = (t + 1 < TOPK) ? t + 1 : TOPK;
        { int sv[4];
#pragma unroll
          for (int i = 0; i < 4; ++i) sv[i] = sel[m * TOPK + lane + 64 * i];
#pragma unroll
          for (int i = 0; i < 4; ++i) { const int j = lane + 64 * i; il[j] = (unsigned short)((j < nsel && (unsigned)sv[i] < (unsigned)T) ? sv[i] : 0); } }
        bf16x8 qf[4];
        { const GAS v4u* qp = (const GAS v4u*)(proj + m * NIN + C_DQ + (n * 3 + (c16 < 3 ? c16 : 0)) * 128);
          v4u w[4];
#pragma unroll
          for (int ks = 0; ks < 4; ++ks) w[ks] = qp[ks * 4 + kq];
#pragma unroll
          for (int ks = 0; ks < 4; ++ks) { if (c16 >= 3) w[ks] = (v4u){0u, 0u, 0u, 0u}; qf[ks] = __builtin_bit_cast(bf16x8, w[ks]); } }
        LDS_WAIT(); asm volatile("" ::: "memory");
        const char* kslab = (const char*)((const bf16*)(F.ws + WS_DKC) + ((size_t)(b * 4 + n)) * T * 128);
        const char* vslab = (const char*)((const bf16*)(F.ws + WS_DVC) + ((size_t)(b * 4 + n)) * T * 128);
        f32x4 sc[16];
#define DSA_KDMA(kr) do { LAS unsigned char* dst = vring + ((kr) & 1) * 8192; _Pragma("unroll") for (int i = 0; i < 8; ++i) { \
            const unsigned idx = il[32 * (kr) + 4 * i + (lane >> 4)]; const unsigned off = idx * 256u + (koff ^ (unsigned)((i & 3) << 6)); \
            __builtin_amdgcn_global_load_lds((const GAS unsigned*)(kslab + off), (LAS unsigned*)(dst + i * 1024), 16, 0, 0); } } while (0)
#define DSA_VDMA(kb) do { LAS unsigned char* dst = vring + ((kb) & 1) * 8192; _Pragma("unroll") for (int i = 0; i < 8; ++i) { \
            const unsigned idx = il[32 * (kb) + 4 * i + (lane >> 4)]; const unsigned off = idx * 256u + (((i >> 1) & 1) ? voff1 : voff0); \
            __builtin_amdgcn_global_load_lds((const GAS unsigned*)(vslab + off), (LAS unsigned*)(dst + i * 1024), 16, 0, 0); } } while (0)
#define DSA_KDMA1(kr, i) do { const unsigned idx = il[32 * (kr) + 4 * (i) + (lane >> 4)]; const unsigned off = idx * 256u + (koff ^ (unsigned)(((i) & 3) << 6)); \
            __builtin_amdgcn_global_load_lds((const GAS unsigned*)(kslab + off), (LAS unsigned*)(vring + ((kr) & 1) * 8192 + (i) * 1024), 16, 0, 0); } while (0)
#define DSA_VDMA1(kb, i) do { const unsigned idx = il[32 * (kb) + 4 * (i) + (lane >> 4)]; const unsigned off = idx * 256u + ((((i) >> 1) & 1) ? voff1 : voff0); \
            __builtin_amdgcn_global_load_lds((const GAS unsigned*)(vslab + off), (LAS unsigned*)(vring + ((kb) & 1) * 8192 + (i) * 1024), 16, 0, 0); } while (0)
        DSA_KDMA(0); DSA_KDMA(1);
#pragma unroll
        for (int kr = 0; kr < 8; ++kr) {
            asm volatile("s_waitcnt vmcnt(8)" ::: "memory");
            const LAS unsigned char* ks_ = vring + (kr & 1) * 8192 + c16 * 256;
            bf16x8 af_[2][4];
#pragma unroll
            for (int bi = 0; bi < 2; ++bi)
#pragma unroll
                for (int ks = 0; ks < 4; ++ks) af_[bi][ks] = *(const LAS bf16x8*)(ks_ + bi * 4096 + (((ks * 4 + kq) ^ c16) << 4));
            LDS_WAIT(); asm volatile("" ::: "memory");
            f32x4 acc0 = (f32x4){0.f, 0.f, 0.f, 0.f}, acc1 = (f32x4){0.f, 0.f, 0.f, 0.f};
#pragma unroll
            for (int p = 0; p < 8; ++p) {
                if (p < 4) acc0 = MFMA16(af_[0][p & 3], qf[p & 3], acc0); else acc1 = MFMA16(af_[1][p & 3], qf[p & 3], acc1);
                SCHED_FENCE();
                if (kr + 2 < 8) { DSA_KDMA1(kr + 2, p); } else { DSA_VDMA1(kr - 6, p); }
                SCHED_FENCE();
            }
            sc[2 * kr] = acc0; sc[2 * kr + 1] = acc1;
        }
        if (nsel < TOPK) {
#pragma unroll
            for (int blk = 0; blk < 16; ++blk)
#pragma unroll
                for (int i = 0; i < 4; ++i) { const int j = blk * 16 + 4 * kq + i; if (j >= nsel) sc[blk][i] = -__builtin_inff(); }
        }
        float mx = sc[0][0];
#pragma unroll
        for (int blk = 0; blk < 16; ++blk)
#pragma unroll
            for (int i = 0; i < 4; ++i) mx = fmaxf(mx, sc[blk][i]);
        mx = fmaxf(mx, __shfl_xor(mx, 16)); mx = fmaxf(mx, __shfl_xor(mx, 32));
        if (c16 < 3) {
#pragma unroll
            for (int blk = 0; blk < 16; ++blk) *(LAS f32x4*)(sl + c16 * 256 + blk * 16 + 4 * kq) = sc[blk];
        }
        const float m0 = -rdlane(mx, 0) * C2, m1 = -rdlane(mx, 1) * C2, m2 = -rdlane(mx, 2) * C2;
        LDS_WAIT(); asm volatile("" ::: "memory");
        { const f32x4 s0 = *(const LAS f32x4*)(sl + 4 * lane), s1 = *(const LAS f32x4*)(sl + 256 + 4 * lane), s2 = *(const LAS f32x4*)(sl + 512 + 4 * lane);
          float p0[4], p1[4], p2[4];
#pragma unroll
          for (int e = 0; e < 4; ++e) { p0[e] = __builtin_amdgcn_exp2f(fmaf(s0[e], C2, m0)); p1[e] = __builtin_amdgcn_exp2f(fmaf(s1[e], C2, m1)); p2[e] = __builtin_amdgcn_exp2f(fmaf(s2[e], C2, m2)); }
          LDS_WAIT(); asm volatile("" ::: "memory");
          LAS unsigned char* pb = (LAS unsigned char*)sl;
          *(LAS v2u*)(pb + 8 * lane) = (v2u){cvtpk_s(p0[0], p0[1]), cvtpk_s(p0[2], p0[3])};
          *(LAS v2u*)(pb + 512 + 8 * lane) = (v2u){cvtpk_s(p1[0], p1[1]), cvtpk_s(p1[2], p1[3])};
          *(LAS v2u*)(pb + 1024 + 8 * lane) = (v2u){cvtpk_s(p2[0], p2[1]), cvtpk_s(p2[2], p2[3])}; }
        LDS_WAIT(); asm volatile("" ::: "memory");
        f32x4 oacc[8], lacc = (f32x4){0.f, 0.f, 0.f, 0.f};
#pragma unroll
        for (int d = 0; d < 8; ++d) oacc[d] = (f32x4){0.f, 0.f, 0.f, 0.f};
        const LAS unsigned char* pbr = (const LAS unsigned char*)sl + (c16 < 3 ? c16 : 0) * 512 + kq * 16;
        const int trrow = (8 * kq + trq) * 256; const int trsw = 2 * trq + 8 * (kq & 1);
#pragma unroll 1
        for (int kb = 0; kb < 8; ++kb) {
            if (kb < 7) asm volatile("s_waitcnt vmcnt(8)" ::: "memory"); else asm volatile("s_waitcnt vmcnt(0)" ::: "memory");
            const LAS unsigned char* vs = vring + (kb & 1) * 8192 + trrow + (trp & 1) * 8;
            v4u pw = *(const LAS v4u*)(pbr + kb * 64); if (c16 >= 3) pw = (v4u){0u, 0u, 0u, 0u};
            const bf16x8 pf = __builtin_bit_cast(bf16x8, pw);
            bf16x8 vf_[8];
#pragma unroll
            for (int d = 0; d < 8; ++d) { const int cpos = ((2 * d + (trp >> 1)) ^ trsw) << 4;
                const s16x4 lo = vtr((const LAS char*)(vs + cpos)), hi = vtr((const LAS char*)(vs + 4 * 256 + cpos));
                vf_[d] = __builtin_shufflevector(lo, hi, 0, 1, 2, 3, 4, 5, 6, 7); }
            LDS_WAIT(); asm volatile("" ::: "memory");
            const bool rf = kb + 2 < 8; const int kn = rf ? kb + 2 : 7;
#pragma unroll
            for (int d = 0; d < 8; ++d) {
                oacc[d] = MFMA16(vf_[d], pf, oacc[d]);
                SCHED_FENCE();
                if (rf) { DSA_VDMA1(kn, d); }
                SCHED_FENCE();
            }
            lacc = MFMA16(ones, pf, lacc);
        }
#undef DSA_KDMA1
#undef DSA_VDMA1
#undef DSA_KDMA
#undef DSA_VDMA
        if (c16 < 3) { const float il_ = 1.f / lacc[0]; bf16* orow = mix + m * MIXW + MIX_DSA + (n * 3 + c16) * 128 + 4 * kq;
#pragma unroll
            for (int d = 0; d < 8; ++d) *(GAS v2u*)(orow + 16 * d) = (v2u){cvtpk_s(oacc[d][0] * il_, oacc[d][1] * il_), cvtpk_s(oacc[d][2] * il_, oacc[d][3] * il_)}; }
        asm volatile("s_waitcnt vmcnt(0) lgkmcnt(0)" ::: "memory");
    }
}

struct Args { const float* in[12]; float* out; unsigned char* ws; };
__device__ __forceinline__ void grid_bar(LAS unsigned char* lds, const int wave_s) {
    XcdBarrier b; b.bar = (unsigned*)(KA_WS() + WS_CTL) + CW_BAR; b.x = xb_xcc_id(); b.st = (volatile LAS unsigned*)(lds + MISC_OFF) + 8;
    xcd_barrier(b, tid_now(wave_s));
}
__global__ void __launch_bounds__(NWAVES * 64, 2) fwd_kernel(Args args) {
    extern __shared__ __attribute__((aligned(16))) unsigned char lds_raw[];
    LAS unsigned char* lds = (LAS unsigned char*)lds_raw;
    const int wave_s = __builtin_amdgcn_readfirstlane((int)threadIdx.x >> 6);
    for (int u = threadIdx.x; u < (LDS_BYTES - LDSCTL_OFF) / 4; u += NWAVES * 64) ((LAS unsigned*)(lds + LDSCTL_OFF))[u] = 0u;
    __syncthreads();
    (void)xcd_barrier_post((unsigned*)(KA_WS() + WS_CTL) + CW_BAR, (volatile LAS unsigned*)(lds + MISC_OFF) + 8);
#define GRID_BAR() grid_bar(lds, wave_s)
#define WSP(T_, off) ((T_*)(ws + (off)))

    p0_prologue(lds, wave_s);
    GRID_BAR();

#pragma unroll 1
    for (int l = 0; l < DEPTH; ++l) {
        const int Gg = inproj_gemm_wgs(NWG);
        if ((int)blockIdx.x >= Gg) side_convert(lds, wave_s, l, (int)blockIdx.x - Gg, NWG - Gg);
        else
        { unsigned char* ws = KA_WS(); unsigned char* wl = ws + WS_W + (size_t)l * SZ_WLAYER;
          pg8::Gemm g{WSP(bf16, WS_U), (const bf16*)(wl + OFF_WIN), M, NIN, DM}; pg8::StaticOrder S; S.init(M, NIN, Gg, (int)blockIdx.x);
          pg8::EpiBf16<0> E{WSP(bf16, WS_PROJ), NIN, 0, (const float*)(ws + WS_CTL) + CW_ROWSS + (size_t)(2 * l) * M, 1.0f / DM};
          pg8::gemm_phase<pg8::EpiBf16<0>, pg8::StaticOrder, true, true>(lds + RING_OFF, g, S, E, tid_now(wave_s)); }
        if (Gg == NWG) side_convert(lds, wave_s, l, (int)blockIdx.x, NWG);
        GRID_BAR();
        prep_phase(lds, wave_s, l);
        GRID_BAR();
        { unsigned char* ws = KA_WS(); unsigned char* wl = ws + WS_W + (size_t)l * SZ_WLAYER;
          pg8::Gemm g{WSP(bf16, WS_CQN), (const bf16*)(wl + OFF_WUQ), M, NUQ, QL}; pg8::StaticOrder S; S.init(M, NUQ, NWG, (int)((blockIdx.x + NWG / 2) % NWG));
          pg8::EpiBf16<0> E{WSP(bf16, WS_QMLA), NUQ, 0, nullptr, 0.f};
          pg8::gemm_phase<pg8::EpiBf16<0>, pg8::StaticOrder, true, true>(lds + RING_OFF, g, S, E, tid_now(wave_s)); }
        { unsigned char* ws = KA_WS(); unsigned char* wl = ws + WS_W + (size_t)l * SZ_WLAYER;
          pg8::Gemm g{WSP(bf16, WS_CKVN), (const bf16*)(wl + OFF_WUKV), M, NUKV, KVL}; pg8::StaticOrder S; S.init(M, NUKV, NWG, (int)blockIdx.x);
          pg8::EpiBf16<0> E{WSP(bf16, WS_KVMLA), 256, (size_t)M * 256, nullptr, 0.f};
          pg8::gemm_phase<pg8::EpiBf16<0>, pg8::StaticOrder, true, true>(lds + RING_OFF, g, S, E, tid_now(wave_s)); }
        __syncthreads();
        indexer_mfma(lds, wave_s);
        attn_phase<2>(lds, wave_s, l);
        GRID_BAR();
        if ((int)blockIdx.x >= NWG - ATT_CONV) wdn_convert(lds, wave_s, l, (int)blockIdx.x - (NWG - ATT_CONV));
        attn_phase<0>(lds, wave_s, l);
        attn_phase<1>(lds, wave_s, l);
        dsa_fast(lds, wave_s, l);
        GRID_BAR();
        { unsigned char* ws = KA_WS(); unsigned char* wl = ws + WS_W + (size_t)l * SZ_WLAYER;
          pg8::Gemm g{WSP(bf16, WS_MIX), (const bf16*)(wl + OFF_WO), M, DM, MIXW}; pg8::StaticOrder S; S.init(M, DM, NWG, (int)blockIdx.x);
          pg8::EpiRes E{l == 0 ? KA_IN(0) : (const float*)nullptr, (float*)nullptr, DM, WSP(bf16, WS_U), (float*)(ws + WS_CTL) + CW_ROWSS + (size_t)(2 * l + 1) * M};
          pg8::gemm_phase<pg8::EpiRes, pg8::StaticOrder, true, true>(lds + RING_OFF, g, S, E, tid_now(wave_s)); }
        GRID_BAR();
        { unsigned char* ws = KA_WS(); unsigned char* wl = ws + WS_W + (size_t)l * SZ_WLAYER;
          pg8::Gemm g{WSP(bf16, WS_U), (const bf16*)(wl + OFF_WUP), M, FF, DM}; pg8::StaticOrder S; S.init(M, FF, NWG, (int)blockIdx.x);
          pg8::EpiBf16<1> E{WSP(bf16, WS_HID), FF, 0, (const float*)(ws + WS_CTL) + CW_ROWSS + (size_t)(2 * l + 1) * M, 1.0f / DM};
          pg8::gemm_phase<pg8::EpiBf16<1>, pg8::StaticOrder, true, true>(lds + RING_OFF, g, S, E, tid_now(wave_s)); }
        GRID_BAR();
        if (l + 1 < DEPTH)
        { unsigned char* ws = KA_WS(); unsigned char* wl = ws + WS_W + (size_t)l * SZ_WLAYER;
          pg8::Gemm g{WSP(bf16, WS_HID), (const bf16*)(wl + OFF_WDN), M, DM, FF}; pg8::StaticOrder S; S.init(M, DM, NWG, (int)blockIdx.x);
          pg8::EpiRes E{(const float*)nullptr, (float*)nullptr, DM, WSP(bf16, WS_U), (float*)(ws + WS_CTL) + CW_ROWSS + (size_t)(2 * l + 2) * M};
          pg8::gemm_phase<pg8::EpiRes, pg8::StaticOrder, true, true>(lds + RING_OFF, g, S, E, tid_now(wave_s));
          GRID_BAR(); }
        else
        { unsigned char* ws = KA_WS(); unsigned char* wl = ws + WS_W + (size_t)l * SZ_WLAYER;
          pg8::Gemm g{WSP(bf16, WS_HID), (const bf16*)(wl + OFF_WDN), M, DM, FF}; pg8::FinalOrder S; S.init(M, DM, NWG, (int)blockIdx.x);
          pg8::EpiFinal E{WSP(bf16, WS_U), KA_OUT(), DM, (float*)(ws + WS_CTL) + CW_ROWSS + (size_t)(2 * l + 2) * M, KA_IN(11), queue_word(ws, 2, 0)};
          pg8::gemm_phase<pg8::EpiFinal, pg8::FinalOrder, true, true>(lds + RING_OFF, g, S, E, tid_now(wave_s)); }
    }
}

extern "C" void kernel_launch(void* const* d_in, const int* in_sizes, int n_in, void* d_out, int out_size, void* d_ws, size_t ws_size, hipStream_t stream) {
    static int grid = 0;
    if (grid == 0) {
        if (n_in != 12 || in_sizes[0] != M * DM || out_size != M * DM || ws_size < WS_END) {
            fprintf(stderr, "kernel_launch: unexpected shapes (n_in %d in0 %d out %d ws %zu need %zu); nothing launched\n", n_in, n_in > 0 ? in_sizes[0] : -1, out_size, ws_size, (size_t)WS_END); grid = -1; return; }
        int dev = 0, cus = 0, per_cu = 0;
        if (hipGetDevice(&dev) != hipSuccess || hipDeviceGetAttribute(&cus, hipDeviceAttributeMultiprocessorCount, dev) != hipSuccess) { grid = -1; return; }
        if (hipFuncSetAttribute((const void*)fwd_kernel, hipFuncAttributeMaxDynamicSharedMemorySize, LDS_BYTES) != hipSuccess) { fprintf(stderr, "kernel_launch: hipFuncSetAttribute failed\n"); grid = -1; return; }
        if (hipOccupancyMaxActiveBlocksPerMultiprocessor(&per_cu, (const void*)fwd_kernel, NWAVES * 64, LDS_BYTES) != hipSuccess || per_cu < 1)
            fprintf(stderr, "kernel_launch: note: occupancy query reports %d workgroups per CU\n", per_cu);
        (void)hipGetLastError();
        if (cus != NWG) { fprintf(stderr, "kernel_launch: %d CUs, this kernel is built for %d; nothing launched\n", cus, NWG); grid = -1; return; }
        grid = NWG;
    }
    if (grid < 0) return;
    if (hipMemsetAsync((char*)d_ws + WS_CTL, 0, CTL_ZERO_BYTES, stream) != hipSuccess) return;
    Args a{};
    for (int i = 0; i < 12; ++i) a.in[i] = (const float*)d_in[i];
    a.out = (float*)d_out; a.ws = (unsigned char*)d_ws;
    hipLaunchKernelGGL(fwd_kernel, dim3(grid), dim3(NWAVES * 64), LDS_BYTES, stream, a);
    const hipError_t le = hipPeekAtLastError();
    if (le != hipSuccess) fprintf(stderr, "kernel_launch: launch failed: %s\n", hipGetErrorName(le));
}
```
